# Optimizing an MI355X kernel written in HIP

```python
import math
import jax, jax.numpy as jnp
from jax import lax
import numpy as np

D_MODEL = 4096
BATCH = 1
SEQ = 8192
DEPTH = 1

ATTN_HEADS = 8
ATTN_HEAD_DIM = 128
ATTN_V_DIM = 2 * ATTN_HEAD_DIM
ATTN_WIDTH = ATTN_HEADS * ATTN_V_DIM
Q_COLS = ATTN_HEADS * 2 * ATTN_HEAD_DIM
K_COLS = ATTN_HEADS * 2 * ATTN_HEAD_DIM
Q_BLOCK = 128
ROPE_THETA = 500000.0
ROPE_DIM = ATTN_HEAD_DIM // 4

SGU_WIDTH = D_MODEL // 2
SGU_GROUPS = 8
SGU_GROUP_DIM = SGU_WIDTH // SGU_GROUPS
CHUNK = 128

D_FF = 4 * D_MODEL

ALPHA = (2.0 * DEPTH) ** 0.25
BETA = (8.0 * DEPTH) ** -0.25
LN_EPS = 1e-5

IN_WIDTHS = (Q_COLS, K_COLS, ATTN_WIDTH, SGU_WIDTH, SGU_WIDTH, D_MODEL, D_MODEL)
IN_COLS = sum(IN_WIDTHS)
SPLIT_POINTS = tuple(int(c) for c in np.cumsum(IN_WIDTHS)[:-1])

kernel_name = "hybrid_diffattn_chunked_sgu_gated_deepnorm"


def layer_norm(x, g, b):
    xf = x.astype(jnp.float32)
    mu = jnp.mean(xf, axis=-1, keepdims=True)
    var = jnp.mean(jnp.square(xf - mu), axis=-1, keepdims=True)
    y = (xf - mu) * lax.rsqrt(var + LN_EPS) * g.astype(jnp.float32) + b.astype(jnp.float32)
    return y.astype(x.dtype)


def partial_rope(t, pos):
    half = ROPE_DIM // 2
    inv_freq = ROPE_THETA ** (-jnp.arange(0, ROPE_DIM, 2, dtype=jnp.float32) / ROPE_DIM)
    ang = pos.astype(jnp.float32)[:, None] * inv_freq[None, :]
    cos = jnp.cos(ang)[None, :, None, None, :]
    sin = jnp.sin(ang)[None, :, None, None, :]
    rot = t[..., :ROPE_DIM].astype(jnp.float32)
    r1, r2 = rot[..., :half], rot[..., half:]
    rotated = jnp.concatenate([r1 * cos - r2 * sin, r2 * cos + r1 * sin], axis=-1)
    return jnp.concatenate([rotated.astype(t.dtype), t[..., ROPE_DIM:]], axis=-1)


def diff_attention(q, k, v, lam, subln_w, lambda_init):
    B, S = q.shape[0], q.shape[1]
    qh = q.transpose(0, 2, 3, 1, 4)
    kh = k.transpose(0, 2, 3, 1, 4)
    vh = v.transpose(0, 2, 1, 3)
    scale = ATTN_HEAD_DIM ** -0.5
    k_pos = jnp.arange(S)

    def one_block(start):
        qb = lax.dynamic_slice_in_dim(qh, start, Q_BLOCK, axis=3)
        s = jnp.einsum('bhcqd,bhckd->bhcqk', qb, kh).astype(jnp.float32) * scale
        q_pos = start + jnp.arange(Q_BLOCK)
        causal = q_pos[:, None] >= k_pos[None, :]
        s = jnp.where(causal, s, -jnp.inf)
        p = jax.nn.softmax(s, axis=-1)
        a = p[:, :, 0] - lam * p[:, :, 1]
        return jnp.einsum('bhqk,bhkd->bhqd', a.astype(vh.dtype), vh)

    starts = jnp.arange(S // Q_BLOCK) * Q_BLOCK
    o = lax.map(one_block, starts)
    o = o.transpose(1, 0, 3, 2, 4).reshape(B, S, ATTN_HEADS, ATTN_V_DIM)
    of = o.astype(jnp.float32)
    of = of * lax.rsqrt(jnp.mean(jnp.square(of), axis=-1, keepdims=True) + LN_EPS)
    of = of * subln_w.astype(jnp.float32) * (1.0 - lambda_init)
    return of.reshape(B, S, ATTN_WIDTH).astype(v.dtype)


def chunked_sgu(u, s, ln_g, ln_b, w_s, b_s):
    B, S, _ = s.shape
    s = layer_norm(s, ln_g, ln_b)
    sc = s.reshape(B, S // CHUNK, CHUNK, SGU_GROUPS, SGU_GROUP_DIM)
    causal = jnp.tril(jnp.ones((CHUNK, CHUNK), dtype=bool))
    w = jnp.where(causal[None], w_s, 0.0)
    mixed = jnp.einsum('gts,bcsgd->bctgd', w, sc) + b_s.T[None, None, :, :, None]
    return u * mixed.reshape(B, S, SGU_WIDTH)


def setup_inputs(seed: int = 0) -> dict:
    key = jax.random.key(seed)
    ks = jax.random.split(key, 24)
    f32 = jnp.float32
    nrm = lambda k, shape: jax.random.normal(k, shape, dtype=f32)
    L = DEPTH
    return {
        "x": nrm(ks[0], (BATCH, SEQ, D_MODEL)),
        "w_in": nrm(ks[1], (L, D_MODEL, IN_COLS)) * D_MODEL ** -0.5,
        "lambda_q1": nrm(ks[2], (L, ATTN_HEAD_DIM)) * 0.1,
        "lambda_k1": nrm(ks[3], (L, ATTN_HEAD_DIM)) * 0.1,
        "lambda_q2": nrm(ks[4], (L, ATTN_HEAD_DIM)) * 0.1,
        "lambda_k2": nrm(ks[5], (L, ATTN_HEAD_DIM)) * 0.1,
        "subln_w": 1.0 + 0.02 * nrm(ks[6], (L, ATTN_V_DIM)),
        "sgu_ln_g": 1.0 + 0.02 * nrm(ks[7], (L, SGU_WIDTH)),
        "sgu_ln_b": 0.02 * nrm(ks[8], (L, SGU_WIDTH)),
        "w_spatial": nrm(ks[9], (L, SGU_GROUPS, CHUNK, CHUNK)) * CHUNK ** -0.5,
        "b_spatial": 1.0 + 0.02 * nrm(ks[10], (L, SGU_GROUPS, CHUNK)),
        "w_proj_attn": nrm(ks[11], (L, ATTN_WIDTH, D_MODEL)) * ATTN_WIDTH ** -0.5,
        "w_proj_sgu": nrm(ks[12], (L, SGU_WIDTH, D_MODEL)) * SGU_WIDTH ** -0.5,
        "w_out": nrm(ks[13], (L, D_MODEL, D_MODEL)) * (D_MODEL ** -0.5 * BETA),
        "ln1_g": 1.0 + 0.02 * nrm(ks[14], (L, D_MODEL)),
        "ln1_b": 0.02 * nrm(ks[15], (L, D_MODEL)),
        "w_mlp_in": nrm(ks[16], (L, D_MODEL, D_FF)) * D_MODEL ** -0.5,
        "b_mlp_in": 0.02 * nrm(ks[17], (L, D_FF)),
        "w_mlp_out": nrm(ks[18], (L, D_FF, D_MODEL)) * (D_FF ** -0.5 * BETA),
        "b_mlp_out": 0.02 * nrm(ks[19], (L, D_MODEL)),
        "ln2_g": 1.0 + 0.02 * nrm(ks[20], (L, D_MODEL)),
        "ln2_b": 0.02 * nrm(ks[21], (L, D_MODEL)),
    }


def reference(x, w_in, lambda_q1, lambda_k1, lambda_q2, lambda_k2, subln_w,
              sgu_ln_g, sgu_ln_b, w_spatial, b_spatial, w_proj_attn, w_proj_sgu,
              w_out, ln1_g, ln1_b, w_mlp_in, b_mlp_in, w_mlp_out, b_mlp_out,
              ln2_g, ln2_b):
    B, S, _ = x.shape
    pos = jnp.arange(S)
    h = x
    for l in range(DEPTH):
        lambda_init = 0.8 - 0.6 * math.exp(-0.3 * l)
        proj = h @ w_in[l]
        q, k, v, u, s, g_a, g_b = jnp.split(proj, SPLIT_POINTS, axis=-1)
        q = partial_rope(q.reshape(B, S, ATTN_HEADS, 2, ATTN_HEAD_DIM), pos)
        k = partial_rope(k.reshape(B, S, ATTN_HEADS, 2, ATTN_HEAD_DIM), pos)
        v = v.reshape(B, S, ATTN_HEADS, ATTN_V_DIM)
        lam = (jnp.exp(jnp.sum(lambda_q1[l].astype(jnp.float32) * lambda_k1[l].astype(jnp.float32)))
               - jnp.exp(jnp.sum(lambda_q2[l].astype(jnp.float32) * lambda_k2[l].astype(jnp.float32)))
               + lambda_init)
        y_a = diff_attention(q, k, v, lam, subln_w[l], lambda_init)
        y_b = chunked_sgu(jax.nn.gelu(u), jax.nn.gelu(s), sgu_ln_g[l], sgu_ln_b[l],
                          w_spatial[l], b_spatial[l])
        merged = (jax.nn.sigmoid(g_a) * (y_a @ w_proj_attn[l])
                  + jax.nn.sigmoid(g_b) * (y_b @ w_proj_sgu[l]))
        mix = merged @ w_out[l]
        h = layer_norm(ALPHA * h + mix, ln1_g[l], ln1_b[l])
        z = jax.nn.relu(h @ w_mlp_in[l] + b_mlp_in[l])
        ff = (z * z) @ w_mlp_out[l] + b_mlp_out[l]
        h = layer_norm(ALPHA * h + ff, ln2_g[l], ln2_b[l])
    return h
```

```cpp
#include <hip/hip_runtime.h>
#include <hip/hip_bf16.h>
#include <cstdio>
#include <cstdint>
namespace pg8 {
#define PG8_LAS __attribute__((address_space(3)))
typedef unsigned short bf16_t;
typedef short bf16x8 __attribute__((ext_vector_type(8)));
typedef float f32x4 __attribute__((ext_vector_type(4)));
typedef unsigned u32x4 __attribute__((ext_vector_type(4)));
typedef int i32x4 __attribute__((ext_vector_type(4)));
typedef int i32x8 __attribute__((ext_vector_type(8)));
constexpr int BM = 256, BK = 64, HALF = 128, HTB = HALF * BK * 2  , STAGE_BYTES = 8 * HTB, NXCD = 8, WGM = 8;

__host__ __device__ __forceinline__ int lds_byte(int r, int c) { const int st = (r >> 4) * 2 + (c >> 5), rr = r & 15, cc = c & 31, ob = rr * 64 + cc * 2; return st * 1024 + (ob ^ (((ob >> 9) & 1) << 5)); }
__host__ __device__ __forceinline__ void stage_rc(int b, int& R, int& C) { const int st = b / 1024, sb = b % 1024, swz = sb ^ (((sb >> 9) & 1) << 5); R = (st >> 1) * 16 + swz / 64; C = (st & 1) * 32 + (swz % 64) / 2; }
__host__ __device__ __forceinline__ int perm32(int rho) { const int n = rho >> 4, i = rho & 15; return 8 * (i >> 2) + 4 * n + (i & 3); }

struct Unit { int pm, pn; };
struct Gemm { const bf16_t* A; const bf16_t* Bt; int M, N, K; };

struct StaticOrder {
    int nM, nN, nwg, G, c;
    __host__ __device__ void init(int M, int N, int G_, int c_) { nM = M / BM; nN = N / BM; nwg = nM * nN; G = G_; c = c_; }
    __host__ __device__ bool next(int i, Unit& u) const {
        const long L = (long)i * G + c; if (L >= nwg) return false;
        int wgid = (int)L; { const int q = nwg / NXCD, r = nwg % NXCD, xcd = wgid % NXCD, off = wgid / NXCD; wgid = (xcd < r ? xcd * (q + 1) : r * (q + 1) + (xcd - r) * q) + off; }
        const int nig = WGM * nN, gid = wgid / nig, fm = gid * WGM, gsz = (nM - fm) < WGM ? (nM - fm) : WGM;
        u.pm = fm + ((wgid % nig) % gsz); u.pn = (wgid % nig) / gsz; return true;
    }
    __device__ __forceinline__ void a_ready(const Unit&) const {}
    __device__ __forceinline__ void done(const Unit&) const {}
};


typedef float f32x2_t __attribute__((ext_vector_type(2))); typedef __bf16 bf16x2_t __attribute__((ext_vector_type(2)));
__device__ __forceinline__ unsigned cvt_pk_bf16(float lo, float hi) { const f32x2_t v = {lo, hi}; const bf16x2_t b = __builtin_convertvector(v, bf16x2_t); return __builtin_bit_cast(unsigned, b); }
__device__ __forceinline__ float bf_lo(unsigned w) { return __uint_as_float(w << 16); }
__device__ __forceinline__ float bf_hi(unsigned w) { return __uint_as_float(w & 0xffff0000u); }
__device__ __forceinline__ float sigmoid_f(float x) { return __builtin_amdgcn_rcpf(1.0f + __builtin_amdgcn_exp2f(-1.4426950408889634f * x)); }
__device__ __forceinline__ float gelu_tanh_f(float x) { const float y = x * (1.0f + 0.044715f * x * x); return x * __builtin_amdgcn_rcpf(1.0f + __builtin_amdgcn_exp2f(-2.302208198144325f * y)); }
__device__ __forceinline__ u32x4 pack8(const f32x4 v0, const f32x4 v1) { u32x4 w; w.x = cvt_pk_bf16(v0[0], v0[1]); w.y = cvt_pk_bf16(v0[2], v0[3]); w.z = cvt_pk_bf16(v1[0], v1[1]); w.w = cvt_pk_bf16(v1[2], v1[3]); return w; }

constexpr int SEQ_ = 8192;
struct EpiProj {
    static constexpr bool PERM = true, AFTER_DRAIN = false, MIDK = false;
    bf16_t *QKV, *GUS, *SG; const float* rope; const float* rs;
    static __device__ __forceinline__ f32x4 deq(const f32x4 a, float sc) { const i32x4 q = __builtin_bit_cast(i32x4, a); return (f32x4){(float)q[0] * sc, (float)q[1] * sc, (float)q[2] * sc, (float)q[3] * sc}; }
    __device__ __forceinline__ void operator()(const f32x4 (&acc)[2][2][4][2], const Unit& u, int wr, int wc, int fr, int fq) const {
        const int row0 = u.pm * BM + wr * 64 + fr, pn = u.pn;
        if (pn < 24) {
            const int sect = pn >> 3;
            bf16_t* base = QKV + (size_t)sect * ((size_t)SEQ_ * 2048);
            const bool do_rope = (sect < 2) && (wc == 0);
            const float sg = (fq & 2) ? 1.f : -1.f;
#pragma unroll
            for (int bj = 0; bj < 2; ++bj) {
                bf16_t* dst = base + (size_t)((pn & 7) * 2 + bj) * ((size_t)SEQ_ * 128) + wc * 32 + 8 * fq;
#pragma unroll
                for (int ai = 0; ai < 2; ++ai)
#pragma unroll
                    for (int m = 0; m < 4; ++m) { const int row = row0 + ai * HALF + m * 16; const float sc = rs[row];
                        f32x4 v0 = deq(acc[ai][bj][m][0], sc), v1 = deq(acc[ai][bj][m][1], sc);
                        if (do_rope) {
                            f32x4 p0, p1;
#pragma unroll
                            for (int e = 0; e < 4; ++e) { p0[e] = __shfl_xor(v0[e], 32); p1[e] = __shfl_xor(v1[e], 32); }
                            const f32x4* t = (const f32x4*)(rope + ((size_t)row * 16 + 8 * (fq & 1)) * 2);
                            const f32x4 t0 = t[0], t1 = t[1], t2 = t[2], t3 = t[3];
                            v0[0] = v0[0] * t0[0] + sg * p0[0] * t0[1]; v0[1] = v0[1] * t0[2] + sg * p0[1] * t0[3];
                            v0[2] = v0[2] * t1[0] + sg * p0[2] * t1[1]; v0[3] = v0[3] * t1[2] + sg * p0[3] * t1[3];
                            v1[0] = v1[0] * t2[0] + sg * p1[0] * t2[1]; v1[1] = v1[1] * t2[2] + sg * p1[1] * t2[3];
                            v1[2] = v1[2] * t3[0] + sg * p1[2] * t3[1]; v1[3] = v1[3] * t3[2] + sg * p1[3] * t3[3];
                        }
                        *(u32x4*)(dst + (size_t)row * 128) = pack8(v0, v1); }
            }
        } else {
            const bool gel = pn < 40;
            const int rel = gel ? pn - 24 : pn - 40, ldc = gel ? 2048 : 4096, per = gel ? 8 : 16, which = rel >= per ? 1 : 0, colt = (rel - which * per) * BM;
            bf16_t* base = (gel ? GUS : SG) + (size_t)which * ((size_t)SEQ_ * ldc);
            const int col0 = colt + wc * 32 + 8 * fq;
#pragma unroll
            for (int ai = 0; ai < 2; ++ai)
#pragma unroll
                for (int m = 0; m < 4; ++m) { const int row = row0 + ai * HALF + m * 16; const float sc = rs[row]; bf16_t* rowp = base + (size_t)row * ldc + col0;
#pragma unroll
                    for (int bj = 0; bj < 2; ++bj) { f32x4 v0 = deq(acc[ai][bj][m][0], sc), v1 = deq(acc[ai][bj][m][1], sc);
                        if (gel) {
#pragma unroll
                            for (int e = 0; e < 4; ++e) { v0[e] = gelu_tanh_f(v0[e]); v1[e] = gelu_tanh_f(v1[e]); } }
                        else {
#pragma unroll
                            for (int e = 0; e < 4; ++e) { v0[e] = sigmoid_f(v0[e]); v1[e] = sigmoid_f(v1[e]); } }
                        *(u32x4*)(rowp + bj * HALF) = pack8(v0, v1); } }
        }
    }
};
struct EpiGates {
    static constexpr bool PERM = true, AFTER_DRAIN = false, MIDK = false;
    bf16_t* SG;
    __device__ __forceinline__ void operator()(const f32x4 (&acc)[2][2][4][2], const Unit& u, int wr, int wc, int fr, int fq) const {
        const int row0 = u.pm * BM + wr * 64 + fr, which = u.pn >> 4, col0 = (u.pn & 15) * BM + wc * 32 + 8 * fq;
        bf16_t* base = SG + (size_t)which * ((size_t)SEQ_ * 4096);
#pragma unroll
        for (int ai = 0; ai < 2; ++ai)
#pragma unroll
            for (int m = 0; m < 4; ++m) { bf16_t* rowp = base + (size_t)(row0 + ai * HALF + m * 16) * 4096 + col0;
#pragma unroll
                for (int bj = 0; bj < 2; ++bj) { f32x4 v0 = acc[ai][bj][m][0], v1 = acc[ai][bj][m][1];
#pragma unroll
                    for (int e = 0; e < 4; ++e) { v0[e] = sigmoid_f(v0[e]); v1[e] = sigmoid_f(v1[e]); }
                    *(u32x4*)(rowp + bj * HALF) = pack8(v0, v1); } }
    }
};
template <bool FIRST> struct EpiGate {
    static constexpr bool PERM = true, AFTER_DRAIN = false, MIDK = false;
    const bf16_t* gate; bf16_t* MG;
    __device__ __forceinline__ void operator()(const f32x4 (&acc)[2][2][4][2], const Unit& u, int wr, int wc, int fr, int fq) const {
        const int row0 = u.pm * BM + wr * 64 + fr, col0 = u.pn * BM + wc * 32 + 8 * fq;
#pragma unroll
        for (int ai = 0; ai < 2; ++ai)
#pragma unroll
            for (int m = 0; m < 4; ++m) { const size_t off = (size_t)(row0 + ai * HALF + m * 16) * 4096 + col0;
#pragma unroll
                for (int bj = 0; bj < 2; ++bj) { const u32x4 gw = *(const u32x4*)(gate + off + bj * HALF);
                    f32x4 v0 = acc[ai][bj][m][0], v1 = acc[ai][bj][m][1];
                    v0[0] *= bf_lo(gw.x); v0[1] *= bf_hi(gw.x); v0[2] *= bf_lo(gw.y); v0[3] *= bf_hi(gw.y);
                    v1[0] *= bf_lo(gw.z); v1[1] *= bf_hi(gw.z); v1[2] *= bf_lo(gw.w); v1[3] *= bf_hi(gw.w);
                    if (!FIRST) { const u32x4 mw = *(const u32x4*)(MG + off + bj * HALF);
                        v0[0] += bf_lo(mw.x); v0[1] += bf_hi(mw.x); v0[2] += bf_lo(mw.y); v0[3] += bf_hi(mw.y);
                        v1[0] += bf_lo(mw.z); v1[1] += bf_hi(mw.z); v1[2] += bf_lo(mw.w); v1[3] += bf_hi(mw.w); }
                    *(u32x4*)(MG + off + bj * HALF) = pack8(v0, v1); } }
    }
};
struct EpiGate2 {
    static constexpr bool PERM = true, AFTER_DRAIN = false, MIDK = true;
    const bf16_t* ga; const bf16_t* gb; bf16_t* MG;
    __device__ __forceinline__ void mid(f32x4 (&acc)[2][2][4][2], const Unit& u, int wr, int wc, int fr, int fq) const {
        int row0 = u.pm * BM + wr * 64 + fr; const int col0 = u.pn * BM + wc * 32 + 8 * fq;
        asm volatile("" : "+v"(row0));
#pragma unroll
        for (int ai = 0; ai < 2; ++ai)
#pragma unroll
            for (int m = 0; m < 4; ++m) { const size_t off = (size_t)(row0 + ai * HALF + m * 16) * 4096 + col0;
#pragma unroll
                for (int bj = 0; bj < 2; ++bj) { const u32x4 a = *(const u32x4*)(ga + off + bj * HALF), b = *(const u32x4*)(gb + off + bj * HALF);
                    f32x4 r0 = {bf_lo(b.x), bf_hi(b.x), bf_lo(b.y), bf_hi(b.y)}, r1 = {bf_lo(b.z), bf_hi(b.z), bf_lo(b.w), bf_hi(b.w)};
#pragma unroll
                    for (int e = 0; e < 4; ++e) { r0[e] = __builtin_amdgcn_rcpf(fmaxf(r0[e], 1e-30f)); r1[e] = __builtin_amdgcn_rcpf(fmaxf(r1[e], 1e-30f)); }
                    const f32x4 a0 = {bf_lo(a.x), bf_hi(a.x), bf_lo(a.y), bf_hi(a.y)}, a1 = {bf_lo(a.z), bf_hi(a.z), bf_lo(a.w), bf_hi(a.w)};
                    acc[ai][bj][m][0] *= a0 * r0; acc[ai][bj][m][1] *= a1 * r1;
                    asm volatile("" : "+v"(acc[ai][bj][m][0]), "+v"(acc[ai][bj][m][1])); asm volatile("" ::: "memory"); } }
    }
    __device__ __forceinline__ void operator()(const f32x4 (&acc)[2][2][4][2], const Unit& u, int wr, int wc, int fr, int fq) const {
        int row0 = u.pm * BM + wr * 64 + fr; const int col0 = u.pn * BM + wc * 32 + 8 * fq;
        asm volatile("" : "+v"(row0));
#pragma unroll
        for (int ai = 0; ai < 2; ++ai)
#pragma unroll
            for (int m = 0; m < 4; ++m) { const size_t off = (size_t)(row0 + ai * HALF + m * 16) * 4096 + col0;
#pragma unroll
                for (int bj = 0; bj < 2; ++bj) { const u32x4 b = *(const u32x4*)(gb + off + bj * HALF);
                    f32x4 v0 = acc[ai][bj][m][0], v1 = acc[ai][bj][m][1];
                    v0[0] *= bf_lo(b.x); v0[1] *= bf_hi(b.x); v0[2] *= bf_lo(b.y); v0[3] *= bf_hi(b.y);
                    v1[0] *= bf_lo(b.z); v1[1] *= bf_hi(b.z); v1[2] *= bf_lo(b.w); v1[3] *= bf_hi(b.w);
                    *(u32x4*)(MG + off + bj * HALF) = pack8(v0, v1); } }
    }
};
struct EpiRes {
    static constexpr bool PERM = false, AFTER_DRAIN = false, MIDK = false;
    const float* res; float* out; const float* bias; float alpha;
    __device__ __forceinline__ void operator()(const f32x4 (&acc)[2][2][4][2], const Unit& u, int wr, int wc, int fr, int fq) const {
        const int row0 = u.pm * BM + wr * 64 + fr, col0 = u.pn * BM + wc * 32 + 4 * fq;
        f32x4 bv[2][2];
#pragma unroll
        for (int bj = 0; bj < 2; ++bj)
#pragma unroll
            for (int n = 0; n < 2; ++n) bv[bj][n] = bias ? *(const f32x4*)(bias + col0 + bj * HALF + n * 16) : (f32x4){0.f, 0.f, 0.f, 0.f};
#pragma unroll
        for (int ai = 0; ai < 2; ++ai)
#pragma unroll
            for (int m = 0; m < 4; ++m) { const size_t off = (size_t)(row0 + ai * HALF + m * 16) * 4096 + col0;
#pragma unroll
                for (int bj = 0; bj < 2; ++bj)
#pragma unroll
                    for (int n = 0; n < 2; ++n) { const f32x4 r = *(const f32x4*)(res + off + bj * HALF + n * 16);
                        *(f32x4*)(out + off + bj * HALF + n * 16) = r * alpha + (acc[ai][bj][m][n] + bv[bj][n]); } }
    }
};
template <bool RES_BF16> struct EpiResB {
    static constexpr bool PERM = true, AFTER_DRAIN = false, MIDK = false;
    const void* res; bf16_t* out; const float* bias; float alpha;
    __device__ __forceinline__ void operator()(const f32x4 (&acc)[2][2][4][2], const Unit& u, int wr, int wc, int fr, int fq) const {
        const int row0 = u.pm * BM + wr * 64 + fr, col0 = u.pn * BM + wc * 32 + 8 * fq;
        f32x4 bv[2][2];
#pragma unroll
        for (int bj = 0; bj < 2; ++bj)
#pragma unroll
            for (int n = 0; n < 2; ++n) bv[bj][n] = bias ? *(const f32x4*)(bias + col0 + bj * HALF + 4 * n) : (f32x4){0.f, 0.f, 0.f, 0.f};
#pragma unroll
        for (int ai = 0; ai < 2; ++ai)
#pragma unroll
            for (int m = 0; m < 4; ++m) { const size_t off = (size_t)(row0 + ai * HALF + m * 16) * 4096 + col0;
#pragma unroll
                for (int bj = 0; bj < 2; ++bj) { f32x4 r0, r1;
                    if (RES_BF16) { const u32x4 w = *(const u32x4*)((const bf16_t*)res + off + bj * HALF);
                        r0 = (f32x4){bf_lo(w.x), bf_hi(w.x), bf_lo(w.y), bf_hi(w.y)}; r1 = (f32x4){bf_lo(w.z), bf_hi(w.z), bf_lo(w.w), bf_hi(w.w)}; }
                    else { r0 = *(const f32x4*)((const float*)res + off + bj * HALF); r1 = *(const f32x4*)((const float*)res + off + bj * HALF + 4); }
                    const f32x4 v0 = r0 * alpha + (acc[ai][bj][m][0] + bv[bj][0]), v1 = r1 * alpha + (acc[ai][bj][m][1] + bv[bj][1]);
                    *(u32x4*)(out + off + bj * HALF) = pack8(v0, v1); } }
    }
};
template <bool DQ = false> struct EpiRelu2 {
    static constexpr bool PERM = true, AFTER_DRAIN = false, MIDK = false;
    bf16_t* Z; int ldc; const float* bias; const float* rs = nullptr;
    __device__ __forceinline__ void operator()(const f32x4 (&acc)[2][2][4][2], const Unit& u, int wr, int wc, int fr, int fq) const {
        const int row0 = u.pm * BM + wr * 64 + fr, col0 = u.pn * BM + wc * 32 + 8 * fq;
        f32x4 bv[2][2];
#pragma unroll
        for (int bj = 0; bj < 2; ++bj)
#pragma unroll
            for (int n = 0; n < 2; ++n) bv[bj][n] = *(const f32x4*)(bias + col0 + bj * HALF + 4 * n);
#pragma unroll
        for (int ai = 0; ai < 2; ++ai)
#pragma unroll
            for (int m = 0; m < 4; ++m) { bf16_t* rowp = Z + (size_t)(row0 + ai * HALF + m * 16) * ldc + col0; const float sc = DQ ? rs[row0 + ai * HALF + m * 16] : 1.f;
#pragma unroll
                for (int bj = 0; bj < 2; ++bj) { f32x4 v0 = (DQ ? EpiProj::deq(acc[ai][bj][m][0], sc) : acc[ai][bj][m][0]) + bv[bj][0], v1 = (DQ ? EpiProj::deq(acc[ai][bj][m][1], sc) : acc[ai][bj][m][1]) + bv[bj][1];
#pragma unroll
                    for (int e = 0; e < 4; ++e) { const float a = fmaxf(v0[e], 0.f), b = fmaxf(v1[e], 0.f); v0[e] = a * a; v1[e] = b * b; }
                    *(u32x4*)(rowp + bj * HALF) = pack8(v0, v1); } }
    }
};

template <class Epi, class Sched, bool ALIGN_EPI = false, bool SP2 = false, bool FP8 = false, bool I8 = false>
__device__ __forceinline__ void gemm_phase(PG8_LAS unsigned char* lds, const Gemm g, const Sched& S, const Epi& E) {
    const int tid = threadIdx.x, wid = __builtin_amdgcn_readfirstlane(tid >> 6), lane = tid & 63, wr = wid >> 2, wc = wid & 3, fr = lane & 15, fq = lane >> 4;
    const int K = (FP8 || I8) ? g.K / 2 : g.K, nt = K / BK;
    unsigned voffA[2], voffB[2];
#pragma unroll
    for (int i = 0; i < 2; ++i) { int R, C; stage_rc(tid * 16 + i * 8192, R, C); const int Rb = Epi::PERM ? ((R & ~31) + perm32(R & 31)) : R;
        voffA[i] = (unsigned)(R * K + C) * 2u; voffB[i] = (unsigned)(Rb * K + C) * 2u; }
    const size_t kstep = (size_t)(BK * 2);
    const size_t hstep = (size_t)HALF * K * 2;
    const size_t tstep = 2 * hstep;
    const unsigned ldsw = (unsigned)wid * 1024u;
    const int aoff = lds_byte(wr * 64 + fr, fq * 8), boff = lds_byte(wc * 32 + fr, fq * 8);
#define PG8_SA(b, h) (((b) * 2 + (h)) * HTB)
#define PG8_SB(b, h) ((4 + (b) * 2 + (h)) * HTB)
#define PG8_STAGE(bufoff, gbase, voff) do { _Pragma("unroll") for (int _i = 0; _i < 2; ++_i) \
        __builtin_amdgcn_global_load_lds((const unsigned*)((const char*)(gbase) + (voff)[_i]), (PG8_LAS unsigned*)(lds + (bufoff) + ldsw + _i * 8192), 16, 0, 0); } while (0)
#define PG8_LDA(dst, b, h) do { if constexpr (FP8) { _Pragma("unroll") for (int m = 0; m < 4; ++m) { const i32x4 lo_ = *(const PG8_LAS i32x4*)(lds + PG8_SA(b, h) + aoff + m * 2048), hi_ = *(const PG8_LAS i32x4*)(lds + PG8_SA(b, h) + aoff + m * 2048 + 1024); \
            dst##8[m] = __builtin_shufflevector(lo_, hi_, 0, 1, 2, 3, 4, 5, 6, 7); } } \
        else { _Pragma("unroll") for (int m = 0; m < 4; ++m) _Pragma("unroll") for (int k = 0; k < 2; ++k) dst[m][k] = *(const PG8_LAS bf16x8*)(lds + PG8_SA(b, h) + aoff + m * 2048 + k * 1024); } } while (0)
#define PG8_LDB(dst, b, h) do { if constexpr (FP8) { _Pragma("unroll") for (int n = 0; n < 2; ++n) { const i32x4 lo_ = *(const PG8_LAS i32x4*)(lds + PG8_SB(b, h) + boff + n * 2048), hi_ = *(const PG8_LAS i32x4*)(lds + PG8_SB(b, h) + boff + n * 2048 + 1024); \
            dst##8[n] = __builtin_shufflevector(lo_, hi_, 0, 1, 2, 3, 4, 5, 6, 7); } } \
        else { _Pragma("unroll") for (int n = 0; n < 2; ++n) _Pragma("unroll") for (int k = 0; k < 2; ++k) dst[n][k] = *(const PG8_LAS bf16x8*)(lds + PG8_SB(b, h) + boff + n * 2048 + k * 1024); } } while (0)
#define PG8_MMA(ai, bj, At, Bt) do { __builtin_amdgcn_s_setprio(1); \
        if constexpr (FP8) { _Pragma("unroll") for (int m = 0; m < 4; ++m) _Pragma("unroll") for (int n = 0; n < 2; ++n) \
            asm volatile("v_mfma_scale_f32_16x16x128_f8f6f4 %0, %1, %2, %0, %3, %4 op_sel_hi:[0,0,0]" : "+v"(acc[ai][bj][m][n]) : "v"(Bt##8[n]), "v"(At##8[m]), "v"(sc_w8), "v"(sc_a8)); } \
        else if constexpr (I8) { _Pragma("unroll") for (int m = 0; m < 4; ++m) _Pragma("unroll") for (int n = 0; n < 2; ++n) _Pragma("unroll") for (int k = 0; k < 2; ++k) \
            acc[ai][bj][m][n] = __builtin_bit_cast(f32x4, __builtin_amdgcn_mfma_i32_16x16x64_i8(__builtin_bit_cast(i32x4, Bt[n][k]), __builtin_bit_cast(i32x4, At[m][k]), __builtin_bit_cast(i32x4, acc[ai][bj][m][n]), 0, 0, 0)); } \
        else { _Pragma("unroll") for (int m = 0; m < 4; ++m) _Pragma("unroll") for (int n = 0; n < 2; ++n) _Pragma("unroll") for (int k = 0; k < 2; ++k) \
            acc[ai][bj][m][n] = __builtin_amdgcn_mfma_f32_16x16x32_bf16(Bt[n][k], At[m][k], acc[ai][bj][m][n], 0, 0, 0); } \
        __builtin_amdgcn_s_setprio(0); } while (0)
#define PG8_WAIT_V(n) asm volatile("s_waitcnt vmcnt(" #n ")" ::: "memory")
#define PG8_WAIT_L(n) asm volatile("s_waitcnt lgkmcnt(" #n ")" ::: "memory")
#define PG8_BAR __builtin_amdgcn_s_barrier()
#define PG8_SCHED __builtin_amdgcn_sched_barrier(0)
    Unit cur, nxt; int ui = 0;
    if (!S.next(0, cur)) return;
    f32x4 acc[2][2][4][2];
#pragma unroll
    for (int a = 0; a < 2; ++a)
#pragma unroll
        for (int b = 0; b < 2; ++b)
#pragma unroll
            for (int m = 0; m < 4; ++m)
#pragma unroll
                for (int n = 0; n < 2; ++n) acc[a][b][m][n] = (f32x4){0.f, 0.f, 0.f, 0.f};
    const int sc_w8 = 0x79797979, sc_a8 = 0x7F7F7F7F;
    bf16x8 At[4][2], B0[2][2], B1[2][2]; i32x8 At8[4], B08[2], B18[2];
    const char* cA = (const char*)g.A + (size_t)cur.pm * tstep; const char* cB = (const char*)g.Bt + (size_t)cur.pn * tstep;
    S.a_ready(cur);
    if constexpr (SP2) {
        PG8_STAGE(PG8_SB(0, 0), cB, voffB); PG8_STAGE(PG8_SB(0, 1), cB + hstep, voffB); PG8_STAGE(PG8_SA(0, 0), cA, voffA); PG8_STAGE(PG8_SA(0, 1), cA + hstep, voffA);
        if (wr == 1) PG8_BAR;
        PG8_WAIT_V(2); PG8_BAR;
        PG8_STAGE(PG8_SB(1, 0), cB + kstep, voffB); PG8_STAGE(PG8_SA(1, 0), cA + kstep, voffA); PG8_STAGE(PG8_SB(1, 1), cB + hstep + kstep, voffB);
        PG8_WAIT_V(6); PG8_BAR;
    } else {
        PG8_STAGE(PG8_SB(0, 0), cB, voffB); PG8_STAGE(PG8_SA(0, 0), cA, voffA); PG8_STAGE(PG8_SB(0, 1), cB + hstep, voffB); PG8_STAGE(PG8_SA(0, 1), cA + hstep, voffA);
        if (wr == 1) PG8_BAR;
        PG8_WAIT_V(4); PG8_BAR;
        PG8_STAGE(PG8_SB(1, 0), cB + kstep, voffB); PG8_STAGE(PG8_SA(1, 0), cA + kstep, voffA); PG8_STAGE(PG8_SB(1, 1), cB + hstep + kstep, voffB);
        PG8_WAIT_V(6); PG8_BAR;
    }
    for (;;) {
        const bool has_next = S.next(ui + 1, nxt);
        const char* nA = has_next ? (const char*)g.A + (size_t)nxt.pm * tstep : cA; const char* nB = has_next ? (const char*)g.Bt + (size_t)nxt.pn * tstep : cB;
        constexpr int nseg = Epi::MIDK ? 2 : 1; const int tseg = nt / nseg;
        for (int sg = 0; sg < nseg; ++sg) {
        for (int t = sg * tseg; t < (sg + 1) * tseg; t += 2) {
            const bool last = (t == nt - 2);
            const char* a1 = cA + (size_t)(t + 1) * kstep;
            const char* a2 = last ? nA : cA + (size_t)(t + 2) * kstep; const char* b2 = last ? nB : cB + (size_t)(t + 2) * kstep;
            const char* a3 = a2 + kstep; const char* b3 = b2 + kstep;
            if (last && has_next) S.a_ready(nxt);
            if constexpr (SP2) {
            PG8_LDB(B0, 0, 0); PG8_LDB(B1, 0, 1); PG8_SCHED; PG8_LDA(At, 0, 0); PG8_STAGE(PG8_SA(1, 1), a1 + hstep, voffA);
            PG8_WAIT_V(8); PG8_WAIT_L(0); PG8_BAR; PG8_MMA(0, 0, At, B0); PG8_MMA(0, 1, At, B1); PG8_BAR; PG8_SCHED;
            PG8_LDA(At, 0, 1); PG8_STAGE(PG8_SB(0, 0), b2, voffB); PG8_STAGE(PG8_SB(0, 1), b2 + hstep, voffB); PG8_STAGE(PG8_SA(0, 0), a2, voffA);
            PG8_WAIT_V(8); PG8_WAIT_L(0); PG8_BAR; PG8_MMA(1, 0, At, B0); PG8_MMA(1, 1, At, B1); PG8_BAR; PG8_SCHED;
            PG8_LDB(B0, 1, 0); PG8_LDB(B1, 1, 1); PG8_SCHED; PG8_LDA(At, 1, 0); PG8_STAGE(PG8_SA(0, 1), a2 + hstep, voffA);
            PG8_WAIT_V(8); PG8_WAIT_L(0); PG8_BAR; PG8_MMA(0, 0, At, B0); PG8_MMA(0, 1, At, B1); PG8_BAR; PG8_SCHED;
            PG8_LDA(At, 1, 1); PG8_STAGE(PG8_SB(1, 0), b3, voffB); PG8_STAGE(PG8_SB(1, 1), b3 + hstep, voffB); PG8_STAGE(PG8_SA(1, 0), a3, voffA);
            PG8_WAIT_V(8); PG8_WAIT_L(0); PG8_BAR; PG8_MMA(1, 0, At, B0); PG8_MMA(1, 1, At, B1); PG8_BAR; PG8_SCHED;
            } else {
            PG8_LDB(B0, 0, 0); PG8_SCHED; PG8_LDA(At, 0, 0); PG8_STAGE(PG8_SA(1, 1), a1 + hstep, voffA);
            PG8_WAIT_L(8); PG8_BAR; PG8_WAIT_L(0); PG8_MMA(0, 0, At, B0); PG8_BAR; PG8_SCHED;
            PG8_LDB(B1, 0, 1); PG8_STAGE(PG8_SB(0, 0), b2, voffB);
            PG8_BAR; PG8_WAIT_L(0); PG8_MMA(0, 1, At, B1); PG8_BAR;
            PG8_LDA(At, 0, 1); PG8_STAGE(PG8_SA(0, 0), a2, voffA);
            PG8_BAR; PG8_WAIT_L(0); PG8_MMA(1, 0, At, B0); PG8_BAR; PG8_SCHED;
            PG8_STAGE(PG8_SB(0, 1), b2 + hstep, voffB);
            PG8_WAIT_V(6); PG8_BAR; PG8_MMA(1, 1, At, B1); PG8_BAR;
            PG8_LDB(B0, 1, 0); PG8_SCHED; PG8_LDA(At, 1, 0); PG8_STAGE(PG8_SA(0, 1), a2 + hstep, voffA);
            PG8_WAIT_L(8); PG8_BAR; PG8_WAIT_L(0); PG8_MMA(0, 0, At, B0); PG8_BAR; PG8_SCHED;
            PG8_LDB(B1, 1, 1); PG8_STAGE(PG8_SB(1, 0), b3, voffB);
            PG8_BAR; PG8_WAIT_L(0); PG8_MMA(0, 1, At, B1); PG8_BAR;
            PG8_LDA(At, 1, 1); PG8_STAGE(PG8_SA(1, 0), a3, voffA);
            PG8_BAR; PG8_WAIT_L(0); PG8_MMA(1, 0, At, B0); PG8_BAR; PG8_SCHED;
            PG8_STAGE(PG8_SB(1, 1), b3 + hstep, voffB);
            PG8_WAIT_V(6); PG8_BAR; PG8_MMA(1, 1, At, B1); PG8_BAR;
            }
        }
        if constexpr (Epi::MIDK) { if (sg == 0) E.mid(acc, cur, wr, wc, fr, fq); }
        }
        if constexpr (ALIGN_EPI) { if (wr == 0) PG8_BAR; }
        if constexpr (FP8) asm volatile("s_nop 15\n\ts_nop 15" ::: "memory");
        if constexpr (!Epi::AFTER_DRAIN) { E(acc, cur, wr, wc, fr, fq); S.done(cur); }
        if (!has_next) break;
#pragma unroll
        for (int a = 0; a < 2; ++a)
#pragma unroll
            for (int b = 0; b < 2; ++b)
#pragma unroll
                for (int m = 0; m < 4; ++m)
#pragma unroll
                    for (int n = 0; n < 2; ++n) acc[a][b][m][n] = (f32x4){0.f, 0.f, 0.f, 0.f};
        cur = nxt; cA = nA; cB = nB; ++ui;
        if constexpr (ALIGN_EPI) { if (wr == 1) PG8_BAR; }
    }
    PG8_WAIT_V(0);
    if constexpr (!ALIGN_EPI) { if (wr == 0) PG8_BAR; }
    PG8_BAR;
    if constexpr (Epi::AFTER_DRAIN) { E.fused(acc, cur, wr, wc, fr, fq, lds, wid, lane); S.done(cur); }
#undef PG8_SA
#undef PG8_SB
#undef PG8_STAGE
#undef PG8_LDA
#undef PG8_LDB
#undef PG8_MMA
#undef PG8_WAIT_V
#undef PG8_WAIT_L
#undef PG8_BAR
#undef PG8_SCHED
}
}

namespace att {
enum { ORDER_NATURAL = 0, ORDER_REVERSED = 1, ORDER_PAIRED = 2, ORDER_XCD = 4 };
constexpr int B = 1, H = 32, HKV = 32, SQ = 8192, SKV = 8192, D = 128, QOFF = 0, WINDOW = SKV;
constexpr float THR = 8.f;
constexpr bool WSKIP = false;
constexpr float SCALE = 0.08838834764831845f;
constexpr int NW = 8, QBLK = 32, KVBLK = 64, QB = NW * QBLK;
constexpr int SHM_V = KVBLK * D * 2, SHM_K = KVBLK * D * 2;
constexpr int LDS_BYTES = 2 * SHM_V + 2 * SHM_K + NW * 64 * 4;
static_assert(D == 128 && SQ % QB == 0 && SKV % KVBLK == 0 && H % HKV == 0 && QOFF >= 0 && QOFF + SQ <= SKV && WINDOW >= 1, "geometry");

using bf16 = __hip_bfloat16;
typedef short bf16x8 __attribute__((ext_vector_type(8)));
typedef short s16x4 __attribute__((ext_vector_type(4)));
typedef float f32x16 __attribute__((ext_vector_type(16)));
typedef float f32x4 __attribute__((ext_vector_type(4)));
typedef unsigned u32x4 __attribute__((ext_vector_type(4)));
template <class A, class Bt> struct same_t { static constexpr bool v = false; };
template <class A> struct same_t<A, A> { static constexpr bool v = true; };

#define KSWZ(row, colB) ((row) * 256 + ((colB) ^ (((row) & 7) << 4)))
#define SBAR() __builtin_amdgcn_sched_barrier(0)
__device__ __forceinline__ int v_st(int k, int c) { const int kk = (k & ~0xC) | ((k & 4) << 1) | ((k & 8) >> 1); return ((kk >> 3) * 4 + (c >> 5)) * 512 + ((kk & 7) * 32 + (c & 31)) * 2; }
__device__ __forceinline__ int v_rd_base(int lane) { return ((lane & 3) << 3) | (((lane >> 2) & 3) << 6) | (((lane >> 4) & 1) << 5) | (((lane >> 5) & 1) << 8); }
constexpr int v_rd_off(int d0, int ks, int half) { return d0 * 512 + ks * 4096 + half * 2048; }
__device__ __forceinline__ int crow(int r, int hi) { return (r & 3) + 8 * (r >> 2) + 4 * hi; }
__device__ __forceinline__ unsigned cvtpk(float lo, float hi) {
    typedef float f32x2_t __attribute__((ext_vector_type(2))); typedef __bf16 bf16x2_t __attribute__((ext_vector_type(2)));
    const f32x2_t v = {lo, hi}; const bf16x2_t b = __builtin_convertvector(v, bf16x2_t); return __builtin_bit_cast(unsigned, b);
}
__device__ __forceinline__ bf16x8 pack8(f32x4 a, f32x4 b) {
    u32x4 w = {cvtpk(a[0], a[1]), cvtpk(a[2], a[3]), cvtpk(b[0], b[1]), cvtpk(b[2], b[3])};
    return *reinterpret_cast<bf16x8*>(&w);
}
template <class T> __device__ __forceinline__ bf16x8 load8(const T* p) {
    if constexpr (same_t<T, float>::v) { return pack8(*(const f32x4*)p, *(const f32x4*)(p + 4)); }
    else { return *reinterpret_cast<const bf16x8*>(p); }
}
__device__ __forceinline__ void mask_tile(f32x16& p0, f32x16& p1, int dq, unsigned W) {
    const float NEG = -__builtin_inff();
#pragma unroll
    for (int r = 0; r < 16; ++r) {
        const int c = (r & 3) + 8 * (r >> 2);
        if ((unsigned)(dq - c) >= W) p0[r] = NEG;
        if ((unsigned)(dq - c - 32) >= W) p1[r] = NEG;
    }
}
__device__ __forceinline__ void partialSM(f32x16& p0, f32x16& p1, float& m_reg, float& mn, float& alpha) {
    float pmax = p0[0]; for (int r = 1; r < 16; ++r) pmax = fmaxf(pmax, p0[r]); for (int r = 0; r < 16; ++r) pmax = fmaxf(pmax, p1[r]);
    { auto rr = __builtin_amdgcn_permlane32_swap(__float_as_uint(pmax), __float_as_uint(pmax), false, false);
      pmax = fmaxf(__uint_as_float(rr[0]), __uint_as_float(rr[1])); }
    constexpr float C2 = 1.4426950408889634f * SCALE;
    if (__builtin_expect(__all((pmax - m_reg) * SCALE <= THR), 1)) { mn = m_reg; alpha = 1.f; }
    else { mn = fmaxf(m_reg, pmax); alpha = __builtin_amdgcn_exp2f((m_reg - mn) * C2); m_reg = mn; }
    const float mnL = -mn * C2;
    for (int r = 0; r < 16; ++r) p0[r] = fmaf(p0[r], C2, mnL); for (int r = 0; r < 16; ++r) p1[r] = fmaf(p1[r], C2, mnL);
    for (int r = 0; r < 16; ++r) p0[r] = __builtin_amdgcn_exp2f(p0[r]);
}
__device__ __forceinline__ void finishSM(f32x16& p0, f32x16& p1, float alpha, float& l_reg, bf16x8& pa0, bf16x8& pa1, bf16x8& pa2, bf16x8& pa3) {
    for (int r = 0; r < 16; ++r) p1[r] = __builtin_amdgcn_exp2f(p1[r]);
    float ps = 0; for (int r = 0; r < 16; ++r) ps += p0[r]; for (int r = 0; r < 16; ++r) ps += p1[r];
    { auto rr = __builtin_amdgcn_permlane32_swap(__float_as_uint(ps), __float_as_uint(ps), false, false);
      ps = __uint_as_float(rr[0]) + __uint_as_float(rr[1]); }
    l_reg = l_reg * alpha + ps;
#define PK4(P, B_, OUT) do { unsigned a0 = cvtpk(P[B_+0], P[B_+1]), a1 = cvtpk(P[B_+2], P[B_+3]);                          \
        unsigned b0 = cvtpk(P[B_+4], P[B_+5]), b1 = cvtpk(P[B_+6], P[B_+7]);                                             \
        auto r0 = __builtin_amdgcn_permlane32_swap(a0, b0, false, false); auto r1 = __builtin_amdgcn_permlane32_swap(a1, b1, false, false); \
        u32x4 w = {r0[0], r1[0], r0[1], r1[1]}; OUT = *reinterpret_cast<bf16x8*>(&w); } while (0)
    PK4(p0, 0, pa0); PK4(p0, 8, pa1); PK4(p1, 0, pa2); PK4(p1, 8, pa3);
#undef PK4
}
template <int KB, bool SK>
__device__ __forceinline__ void qkt(f32x16& p0, f32x16& p1, const char* K_lds, int r32, int hi, const bf16x8* qr, bool act) {
    if (SK && !act) { const float NEG = -__builtin_inff();
#pragma unroll
        for (int r = 0; r < 16; ++r) { p0[r] = NEG; p1[r] = NEG; } return; }
    p0 = f32x16{}; p1 = f32x16{};
    const char* kb[4];
#pragma unroll
    for (int dd = 0; dd < 4; ++dd) kb[dd] = K_lds + KB * SHM_K + KSWZ(r32, (dd * 16 + hi * 8) * 2);
#pragma unroll
    for (int d0 = 0; d0 < 8; ++d0) { const char* a = kb[d0 & 3] + (d0 >> 2) * 128;
        bf16x8 b0 = *reinterpret_cast<const bf16x8*>(a);
        bf16x8 b1 = *reinterpret_cast<const bf16x8*>(a + 32 * 256);
        p0 = __builtin_amdgcn_mfma_f32_32x32x16_bf16(b0, qr[d0], p0, 0, 0, 0);
        p1 = __builtin_amdgcn_mfma_f32_32x32x16_bf16(b1, qr[d0], p1, 0, 0, 0); }
}
template <int VB, bool SK>
__device__ __forceinline__ void pv_tile(f32x16* o, int vb0, bf16x8 pa0, bf16x8 pa1, bf16x8 pa2, bf16x8 pa3, bool act) {
    if (SK && !act) return;
#define TRRD(dst, off) asm volatile("ds_read_b64_tr_b16 %0, %1 offset:%2" : "=&v"(dst) : "v"(vb0), "i"(off) : "memory")
#define PV_D0(d0) do { s16x4 l0, l1, l2, l3, h0, h1, h2, h3; constexpr int b_ = VB * SHM_V + v_rd_off(d0, 0, 0);     \
        TRRD(l0, b_); TRRD(h0, b_ + 2048); TRRD(l1, b_ + 4096); TRRD(h1, b_ + 6144); TRRD(l2, b_ + 8192); TRRD(h2, b_ + 10240); TRRD(l3, b_ + 12288); TRRD(h3, b_ + 14336); \
        asm volatile("s_waitcnt lgkmcnt(0)" ::: "memory"); SBAR();                 \
        o[d0] = __builtin_amdgcn_mfma_f32_32x32x16_bf16(pa0, (bf16x8){l0[0], l0[1], l0[2], l0[3], h0[0], h0[1], h0[2], h0[3]}, o[d0], 0, 0, 0);   \
        o[d0] = __builtin_amdgcn_mfma_f32_32x32x16_bf16(pa1, (bf16x8){l1[0], l1[1], l1[2], l1[3], h1[0], h1[1], h1[2], h1[3]}, o[d0], 0, 0, 0);   \
        o[d0] = __builtin_amdgcn_mfma_f32_32x32x16_bf16(pa2, (bf16x8){l2[0], l2[1], l2[2], l2[3], h2[0], h2[1], h2[2], h2[3]}, o[d0], 0, 0, 0);   \
        o[d0] = __builtin_amdgcn_mfma_f32_32x32x16_bf16(pa3, (bf16x8){l3[0], l3[1], l3[2], l3[3], h3[0], h3[1], h3[2], h3[3]}, o[d0], 0, 0, 0); } while (0)
    PV_D0(0); PV_D0(1); PV_D0(2); PV_D0(3);
#undef PV_D0
#undef TRRD
}

template <class TIn, class TOut> struct BlockRef { const TIn* Q; const TIn* K; const TIn* V; TOut* O; int P0; };
template <class TIn> struct Seam {
    bf16x8 qr[8];
    bf16x8 st_v0, st_v1, st_k0, st_k1; f32x4 sf0, sf1, sf2, sf3;
    f32x4 tq[16];
};
__device__ __forceinline__ int swa_jlo(int P0, int W) { const int lowk = P0 - W + 1; return lowk > 0 ? lowk / KVBLK : 0; }
#define ROW(p, k0, rr) ((p) + (size_t)((k0) + (rr)) * D + sc)
#define VMW() asm volatile("s_waitcnt vmcnt(0)" ::: "memory")
#define VMWN(n) asm volatile("s_waitcnt vmcnt(%0)" :: "i"(n) : "memory")
#define SLOAD_H(Kp, Vp, k0) do { S.st_v0 = load8<TIn>(ROW(Vp, k0, sr)); S.st_v1 = load8<TIn>(ROW(Vp, k0, 32 + sr));              \
                         S.st_k0 = load8<TIn>(ROW(Kp, k0, sr)); S.st_k1 = load8<TIn>(ROW(Kp, k0, 32 + sr)); } while (0)
#define SWRITE_HK(bf) do { *(bf16x8*)(K_lds + (bf) * SHM_K + kws) = S.st_k0; *(bf16x8*)(K_lds + (bf) * SHM_K + kws + 32 * 256) = S.st_k1; } while (0)
#define SWRITE_HV(bf) do { *(bf16x8*)(V_lds + (bf) * SHM_V + vst0) = S.st_v0; *(bf16x8*)(V_lds + (bf) * SHM_V + vst1) = S.st_v1; } while (0)
#define SWRITE_H(bf) do { SWRITE_HV(bf); SWRITE_HK(bf); } while (0)
#define SLOAD_F(p, k0) do { S.sf0 = *(const f32x4*)ROW(p, k0, sr); S.sf1 = *(const f32x4*)(ROW(p, k0, sr) + 4);                \
                            S.sf2 = *(const f32x4*)ROW(p, k0, 32 + sr); S.sf3 = *(const f32x4*)(ROW(p, k0, 32 + sr) + 4); } while (0)
#define SWRITE_KF(bf) do { *(bf16x8*)(K_lds + (bf) * SHM_K + kws) = pack8(S.sf0, S.sf1); *(bf16x8*)(K_lds + (bf) * SHM_K + kws + 32 * 256) = pack8(S.sf2, S.sf3); } while (0)
#define SWRITE_VF(bf) do { *(bf16x8*)(V_lds + (bf) * SHM_V + vst0) = pack8(S.sf0, S.sf1); *(bf16x8*)(V_lds + (bf) * SHM_V + vst1) = pack8(S.sf2, S.sf3); } while (0)
template <class TIn, class TOut>
__device__ __forceinline__ void causal_swa_prime(const BlockRef<TIn, TOut>& cur, int W, char* lds, Seam<TIn>& S) {
    constexpr bool F32 = same_t<TIn, float>::v;
    const int tid = threadIdx.x, wid = __builtin_amdgcn_readfirstlane(tid >> 6), lane = tid & 63, r32 = lane & 31, hi = lane >> 5;
    const int sr = tid >> 4, sc = (tid & 15) * 8, kws = KSWZ(sr, sc * 2); char* K_lds = lds + 2 * SHM_V;
    const int kb0 = swa_jlo(cur.P0, W) * KVBLK;
    for (int d0 = 0; d0 < 8; ++d0) S.qr[d0] = load8<TIn>(cur.Q + (size_t)(wid * QBLK + r32) * D + d0 * 16 + hi * 8);
    if constexpr (F32) { SLOAD_F((const float*)cur.K, kb0); VMW(); SWRITE_KF(0); SBAR(); SLOAD_F((const float*)cur.V, kb0); }
    else { SLOAD_H(cur.K, cur.V, kb0); VMW(); SWRITE_HK(0); }
    __syncthreads();
}
template <class TIn, class TOut>
__device__ __forceinline__ void causal_swa_block(const BlockRef<TIn, TOut>& cur, const BlockRef<TIn, TOut>& nxt, int skv, int W, char* lds, Seam<TIn>& S) {
    constexpr bool F32 = same_t<TIn, float>::v;
    const int tid = threadIdx.x, wid = __builtin_amdgcn_readfirstlane(tid >> 6), lane = tid & 63, r32 = lane & 31, hi = lane >> 5;
    const int j_lo = swa_jlo(cur.P0, W);
    int j_hi = (cur.P0 + QB - 1) / KVBLK + 1; if (j_hi > skv / KVBLK) j_hi = skv / KVBLK;
    const int NT = j_hi - j_lo;
    const int kbn = swa_jlo(nxt.P0, W) * KVBLK;
    const int qlo = cur.P0 + wid * QBLK, qm = qlo + r32 - 4 * hi;
    char* V_lds = lds; char* K_lds = lds + 2 * SHM_V;
    float* ws = (float*)(lds + 2 * SHM_V + 2 * SHM_K) + wid * 64; float* li_l = ws, * al_l = ws + 32;
    float m_reg = -1e30f, l_reg = 0; f32x16 o[4] = {};
    const int sr = tid >> 4, sc = (tid & 15) * 8, vst0 = v_st(sr, sc), vst1 = v_st(32 + sr, sc), kws = KSWZ(sr, sc * 2);
    const int vb0 = (int)(uintptr_t)V_lds + v_rd_base(lane);
    const TIn* Kh = cur.K; const TIn* Vh = cur.V;
#define RESC(a) do { if (__any((a) < 1.f)) { if (hi == 0) al_l[r32] = (a); asm volatile("s_waitcnt lgkmcnt(0)" ::: "memory");              \
                     for (int d_ = 0; d_ < 4; ++d_) for (int r = 0; r < 16; ++r) o[d_][r] *= al_l[crow(r, hi)]; } } while (0)
#define KBASE(t) ((j_lo + (t)) * KVBLK)
#define ACT(t) (KBASE(t) <= qlo + QBLK - 1 && KBASE(t) + KVBLK - 1 >= qlo - W + 1)
#define MASKT(P0_, P1_, t) do { const int kb_ = KBASE(t); if ((!SK || ACT(t)) && (kb_ + KVBLK - 1 > qlo || kb_ <= qlo + QBLK - 1 - W)) mask_tile(P0_, P1_, qm - kb_, (unsigned)W); } while (0)
    constexpr int NQL = F32 ? 16 : 8;
    constexpr bool SK = WSKIP && !F32;
#define SEAM_K0() do { VMWN(NQL); if constexpr (F32) { SWRITE_KF(0); SBAR(); SLOAD_F((const float*)nxt.V, kbn); } else { SWRITE_HK(0); } SBAR(); } while (0)
    f32x16 pA0, pA1, pB0, pB1; float mnA, mnB, alA, alB; bf16x8 pa0, pa1, pa2, pa3;
    if constexpr (F32) { VMW(); SWRITE_VF(0); SBAR(); } else { SWRITE_HV(0); SBAR(); }
    if (NT > 1) { if constexpr (F32) SLOAD_F((const float*)Kh, KBASE(1)); else SLOAD_H(Kh, Vh, KBASE(1)); }
    SBAR(); qkt<0, SK>(pA0, pA1, K_lds, r32, hi, S.qr, ACT(0));
    if constexpr (F32) { if (NT > 1) { VMW(); SWRITE_KF(1); SBAR(); SLOAD_F((const float*)Vh, KBASE(1)); } }
    MASKT(pA0, pA1, 0); partialSM(pA0, pA1, m_reg, mnA, alA);
    if (NT > 1) { VMW(); if constexpr (F32) { SWRITE_VF(1); SBAR(); if (NT > 2) SLOAD_F((const float*)Kh, KBASE(2)); } else SWRITE_H(1); }
    __syncthreads();
#define HALF_STEP(PX0, PX1, mnX, alX, PY0, PY1, alY, t, KB, VB, SB) do {                                                      \
        SBAR(); qkt<KB, SK>(PX0, PX1, K_lds, r32, hi, S.qr, ACT(t));                                             \
        finishSM(PY0, PY1, alY, l_reg, pa0, pa1, pa2, pa3); SBAR();                                                           \
        if ((t) + 1 < NT) { if constexpr (F32) { VMW(); SWRITE_KF(SB); SBAR(); SLOAD_F((const float*)Vh, KBASE((t) + 1)); }  \
                            else { SLOAD_H(Kh, Vh, KBASE((t) + 1)); } SBAR(); }                                               \
        pv_tile<VB, SK>(o, vb0, pa0, pa1, pa2, pa3, ACT((t) - 1)); MASKT(PX0, PX1, (t)); partialSM(PX0, PX1, m_reg, mnX, alX);                                        \
        __syncthreads();                                                                                                      \
        if ((t) + 1 < NT) { VMW(); if constexpr (F32) { SWRITE_VF(SB); SBAR(); if ((t) + 2 < NT) SLOAD_F((const float*)Kh, KBASE((t) + 2)); } \
                            else { SWRITE_H(SB); } }                                                                          \
        RESC(alX); __syncthreads(); } while (0)
    for (int t = 1; t + 1 < NT; t += 2) {
        HALF_STEP(pB0, pB1, mnB, alB, pA0, pA1, alA, t, 1, 0, 0);
        HALF_STEP(pA0, pA1, mnA, alA, pB0, pB1, alB, t + 1, 0, 1, 1);
    }
    const bool even = (NT & 1) == 0;
    if (even) { SBAR(); qkt<1, SK>(pB0, pB1, K_lds, r32, hi, S.qr, ACT(NT - 1)); SBAR(); }
#define QROW(e) (nxt.Q + (size_t)(wid * QBLK + r32) * D + ((e) >> 1) * 16 + hi * 8 + ((e) & 1) * 4)
    if constexpr (F32) { SLOAD_F((const float*)nxt.K, kbn); SBAR();
#pragma unroll
        for (int e = 0; e < 8; ++e) S.tq[e] = *(const f32x4*)QROW(e); }
    else { SLOAD_H(nxt.K, nxt.V, kbn); SBAR();
#pragma unroll
        for (int d0 = 0; d0 < 8; ++d0) S.qr[d0] = load8<TIn>(nxt.Q + (size_t)(wid * QBLK + r32) * D + d0 * 16 + hi * 8); }
    SBAR();
    finishSM(pA0, pA1, alA, l_reg, pa0, pa1, pa2, pa3); SBAR();
    if constexpr (F32) {
#pragma unroll
        for (int e = 8; e < 16; ++e) S.tq[e] = *(const f32x4*)QROW(e); SBAR(); }
#undef QROW
    pv_tile<0, SK>(o, vb0, pa0, pa1, pa2, pa3, ACT(even ? NT - 2 : NT - 1));
    if (even) { MASKT(pB0, pB1, NT - 1); partialSM(pB0, pB1, m_reg, mnB, alB); __syncthreads(); RESC(alB);
        finishSM(pB0, pB1, alB, l_reg, pa0, pa1, pa2, pa3); SBAR(); pv_tile<1, SK>(o, vb0, pa0, pa1, pa2, pa3, ACT(NT - 1)); }
    SBAR(); SEAM_K0();
    if (hi == 0) li_l[r32] = l_reg; asm volatile("s_waitcnt lgkmcnt(0)" ::: "memory");
    float rli[16];
#pragma unroll
    for (int r = 0; r < 16; ++r) rli[r] = __builtin_amdgcn_rcpf(li_l[crow(r, hi)]);
    TOut* Ow = cur.O + (size_t)(wid * QBLK) * D;
#pragma unroll
    for (int r = 0; r < 16; ++r) { const int orow = crow(r, hi);
#pragma unroll
        for (int d0 = 0; d0 < 4; ++d0) { const float v = o[d0][r] * rli[r];
            if constexpr (same_t<TOut, float>::v) { Ow[(size_t)orow * D + d0 * 32 + r32] = v; }
            else { const float vn = __shfl_xor(v, 1);
                   if ((r32 & 1) == 0) *(unsigned*)(Ow + (size_t)orow * D + d0 * 32 + r32) = cvtpk(v, vn); } } }
    if constexpr (F32) {
#pragma unroll
        for (int d0 = 0; d0 < 8; ++d0) S.qr[d0] = pack8(S.tq[2 * d0], S.tq[2 * d0 + 1]); }
    __syncthreads();
#undef RESC
#undef KBASE
#undef ACT
#undef MASKT
#undef SEAM_K0
#undef HALF_STEP
}
#undef ROW
#undef VMW
#undef VMWN
#undef SLOAD_H
#undef SWRITE_HK
#undef SWRITE_HV
#undef SWRITE_H
#undef SLOAD_F
#undef SWRITE_KF
#undef SWRITE_VF

__host__ __device__ inline int swa_nramp(int nqb, int W, int qoff) { const int t = W - 1 - qoff; const int n = t < 0 ? 0 : t / QB + 1; return n > nqb ? nqb : n; }
__host__ __device__ inline int swa_nx(int nqb, int nramp, int order) { return (order & ORDER_PAIRED) ? (nramp + 1) / 2 + (nqb - nramp) : nqb; }
struct SwaItem { int bh, qb0, qb1; };
__device__ __forceinline__ SwaItem swa_decode(int L, int nb, int nh, int nhkv, int nqb, int nx, int nramp, int order) {
    const int G = nh / nhkv; SwaItem it; int x;
    if ((order & ORDER_XCD) && (nb * nhkv) % 8 == 0) { const int xcd = L & 7, k = L >> 3, per = G * nx, gi = k / per, r = k - gi * per;
        it.bh = (gi * 8 + xcd) * G + r / nx; x = r % nx; }
    else { it.bh = L / nx; x = L - it.bh * nx; }
    if (order & ORDER_PAIRED) { const int ns = nqb - nramp;
        if (x < ns) { it.qb0 = it.qb1 = nqb - 1 - x; } else { it.qb0 = x - ns; it.qb1 = nramp - 1 - it.qb0; } }
    else { it.qb0 = it.qb1 = ((order & 3) == ORDER_REVERSED) ? nqb - 1 - x : x; }
    return it;
}
}

namespace att2 {
using att::bf16; using att::bf16x8; using att::f32x16; using att::QBLK; using att::QB; using att::KVBLK;
constexpr int KSLOT = 16384, VBASE = 32768, VSLOT = 32768, WSF_OFF = 131072 + 1024, LDS_NEED = WSF_OFF + 8 * 64 * 4;
__device__ __forceinline__ void glds16s(const char* sbase, unsigned voff, unsigned lds_dst) { unsigned keep;
    asm volatile("s_mov_b32 %0, m0\n\ts_mov_b32 m0, %3\n\ts_nop 0\n\tglobal_load_lds_dwordx4 %1, %2\n\ts_mov_b32 m0, %0" : "=&s"(keep) : "v"(voff), "s"(sbase), "s"(lds_dst) : "memory"); }
#define A2_WAIT_BAR() asm volatile("s_waitcnt vmcnt(0) lgkmcnt(0)\n\ts_barrier" ::: "memory")
#define A2_DSR128(dst, addr, off) asm volatile("ds_read_b128 %0, %1 offset:%2" : "=&v"(dst) : "v"(addr), "i"(off) : "memory")
#define A2_TRRD(dst, addr, off) asm volatile("ds_read_b64_tr_b16 %0, %1 offset:%2" : "=&v"(dst) : "v"(addr), "i"(off) : "memory")
#define A2_LGKM(n) asm volatile("s_waitcnt lgkmcnt(%0)" :: "i"(n) : "memory")
#define A2_SB() __builtin_amdgcn_sched_barrier(0)
template <int KOFF> __device__ __forceinline__ void qkt_pipe(f32x16& p0, f32x16& p1, const int (&ka)[4], const bf16x8* qr) {
    bf16x8 kf[6];
#define A2_KRD(g) do { A2_DSR128(kf[((g) % 3) * 2], ka[(g) & 3], KOFF + ((g) >> 2) * 128); A2_DSR128(kf[((g) % 3) * 2 + 1], ka[(g) & 3], KOFF + ((g) >> 2) * 128 + 8192); } while (0)
    A2_KRD(0); A2_KRD(1);
    p0 = f32x16{}; p1 = f32x16{};
#pragma unroll
    for (int g = 0; g < 8; ++g) {
        if (g + 2 < 8) { A2_KRD(g + 2); A2_LGKM(4); } else if (g + 1 < 8) { A2_LGKM(2); } else { A2_LGKM(0); }
        A2_SB();
        p0 = __builtin_amdgcn_mfma_f32_32x32x16_bf16(kf[(g % 3) * 2], qr[g], p0, 0, 0, 0);
        p1 = __builtin_amdgcn_mfma_f32_32x32x16_bf16(kf[(g % 3) * 2 + 1], qr[g], p1, 0, 0, 0);
        A2_SB();
    }
#undef A2_KRD
}
__device__ __forceinline__ void pv_pipe(f32x16* o, int vbx, bf16x8 pa0, bf16x8 pa1, bf16x8 pa2, bf16x8 pa3) {
    att::s16x4 vl[2][4], vh[2][4];
#define A2_VRD(g) do { _Pragma("unroll") for (int ks = 0; ks < 4; ++ks) { A2_TRRD(vl[(g) & 1][ks], vbx, ((g) >> 2) * 16384 + ((g) & 3) * 512 + ks * 4096); A2_TRRD(vh[(g) & 1][ks], vbx, ((g) >> 2) * 16384 + ((g) & 3) * 512 + ks * 4096 + 2048); } } while (0)
#define A2_VF(b, k) (bf16x8){vl[b][k][0], vl[b][k][1], vl[b][k][2], vl[b][k][3], vh[b][k][0], vh[b][k][1], vh[b][k][2], vh[b][k][3]}
    A2_VRD(0);
#pragma unroll
    for (int g = 0; g < 8; ++g) {
        if (g + 1 < 8) { A2_VRD(g + 1); A2_LGKM(8); } else { A2_LGKM(0); }
        A2_SB();
        o[g] = __builtin_amdgcn_mfma_f32_32x32x16_bf16(pa0, A2_VF(g & 1, 0), o[g], 0, 0, 0);
        o[g] = __builtin_amdgcn_mfma_f32_32x32x16_bf16(pa1, A2_VF(g & 1, 1), o[g], 0, 0, 0);
        o[g] = __builtin_amdgcn_mfma_f32_32x32x16_bf16(pa2, A2_VF(g & 1, 2), o[g], 0, 0, 0);
        o[g] = __builtin_amdgcn_mfma_f32_32x32x16_bf16(pa3, A2_VF(g & 1, 3), o[g], 0, 0, 0);
        A2_SB();
    }
#undef A2_VRD
#undef A2_VF
}
struct Blk { const bf16* Q; const bf16* K; const bf16* V; float* O; int P0; };
__device__ __forceinline__ void dma_tile(const char* kb, const char* vb, size_t vhi_bytes, unsigned koff, unsigned voff, unsigned lds0, int wid, int ks, int vs) {
    const unsigned dk = (unsigned)__builtin_amdgcn_readfirstlane((int)(lds0 + ks * KSLOT + wid * 1024));
    const unsigned dv = (unsigned)__builtin_amdgcn_readfirstlane((int)(lds0 + VBASE + vs * VSLOT + wid * 1024));
    glds16s(kb, koff, dk); glds16s(kb + 32 * 256, koff, dk + 8192);
    glds16s(vb, voff, dv); glds16s(vb + 32 * 256, voff, dv + 8192);
    glds16s(vb + vhi_bytes, voff, dv + 16384); glds16s(vb + vhi_bytes + 32 * 256, voff, dv + 16384 + 8192);
}
__device__ __forceinline__ void diff_attn_block(const Blk& b, size_t vhi_off, char* lds, int& vs) {
    const int tid = threadIdx.x, wid = __builtin_amdgcn_readfirstlane(tid >> 6), lane = tid & 63, r32 = lane & 31, hi = lane >> 5;
    const int NT = (b.P0 + QB) / KVBLK;
    const int qlo = b.P0 + wid * QBLK, qm = qlo + r32 - 4 * hi;
    const unsigned lds0 = (unsigned)(uintptr_t)lds;
    float* wsf = (float*)(lds + WSF_OFF) + wid * 64; float* li_l = wsf; float* al_l = wsf + 32;
    const int krow = 4 * wid + (lane >> 4);
    const unsigned koff = (unsigned)(krow * 128 + (((lane & 15) ^ (krow & 7)) * 8)) * 2u;
    const int sub = 2 * wid + (lane >> 5), kk = (sub >> 2) * 8 + ((lane & 31) >> 2), vc = (sub & 3) * 32 + (lane & 3) * 8, vk = (kk & ~0xC) | ((kk & 4) << 1) | ((kk & 8) >> 1);
    const unsigned voff = (unsigned)(vk * 128 + vc) * 2u;
    const char* kp = (const char*)b.K; const char* vp = (const char*)b.V;
    const size_t vhi_bytes = vhi_off * 2;
    int vs_prev = vs, vs_cur = vs, vs_next = (vs == 2) ? 0 : vs + 1;
    dma_tile(kp, vp, vhi_bytes, koff, voff, lds0, wid, 0, vs_cur);
    bf16x8 qr[8];
#pragma unroll
    for (int d0 = 0; d0 < 8; ++d0) qr[d0] = att::load8<bf16>(b.Q + (size_t)(wid * QBLK + r32) * 128 + d0 * 16 + hi * 8);
    float m_reg = -1e30f, l_reg = 0.f; f32x16 o[8] = {};
    const int vb0 = (int)lds0 + VBASE + att::v_rd_base(lane);
    int ka[4];
#pragma unroll
    for (int dd = 0; dd < 4; ++dd) ka[dd] = (int)lds0 + KSWZ(r32, (dd * 16 + hi * 8) * 2);
#define A2_ROT() do { vs_prev = vs_cur; vs_cur = vs_next; vs_next = (vs_next == 2) ? 0 : vs_next + 1; } while (0)
#define A2_DMA(KS, t) do { if ((t) + 1 < NT) dma_tile(kp + (size_t)((t) + 1) * (KVBLK * 256), vp + (size_t)((t) + 1) * (KVBLK * 256), vhi_bytes, koff, voff, lds0, wid, (KS) ^ 1, vs_next); } while (0)
#define A2_QKSM(KS, t) do { f32x16 p0, p1; float mn; \
        qkt_pipe<(KS) * KSLOT>(p0, p1, ka, qr); \
        { const int kb_ = (t) * KVBLK; if (kb_ + KVBLK - 1 > qlo) att::mask_tile(p0, p1, qm - kb_, 0x40000000u); } \
        att::partialSM(p0, p1, m_reg, mn, alpha); \
        att::finishSM(p0, p1, alpha, l_reg, pa0, pa1, pa2, pa3); } while (0)
#define A2_PV(VS) do { \
        if (__any(alpha < 1.f)) { if (hi == 0) al_l[r32] = alpha; asm volatile("s_waitcnt lgkmcnt(0)" ::: "memory"); \
            _Pragma("unroll") for (int d_ = 0; d_ < 8; ++d_) _Pragma("unroll") for (int r = 0; r < 16; ++r) o[d_][r] *= al_l[att::crow(r, hi)]; } \
        __builtin_amdgcn_sched_barrier(0); \
        { const int vbx = vb0 + (VS) * VSLOT; \
          pv_pipe(o, vbx, pa0, pa1, pa2, pa3); } } while (0)
    float alpha = 1.f; bf16x8 pa0, pa1, pa2, pa3;
    if (wid < 4) {
        for (int t = 0; t < NT; t += 2) {
            A2_WAIT_BAR(); A2_DMA(0, t);     A2_QKSM(0, t);     A2_PV(vs_cur); A2_ROT();
            A2_WAIT_BAR(); A2_DMA(1, t + 1); A2_QKSM(1, t + 1); A2_PV(vs_cur); A2_ROT();
        }
        A2_WAIT_BAR();
    } else {
        A2_WAIT_BAR();
        A2_DMA(0, 0); A2_QKSM(0, 0); A2_WAIT_BAR(); A2_ROT();
        A2_DMA(1, 1); A2_PV(vs_prev); A2_QKSM(1, 1); A2_WAIT_BAR(); A2_ROT();
        for (int t = 2; t < NT; t += 2) {
            A2_DMA(0, t);     A2_PV(vs_prev); A2_QKSM(0, t);     A2_WAIT_BAR(); A2_ROT();
            A2_DMA(1, t + 1); A2_PV(vs_prev); A2_QKSM(1, t + 1); A2_WAIT_BAR(); A2_ROT();
        }
        A2_PV(vs_prev);
    }
    vs = vs_cur;
#undef A2_ROT
#undef A2_DMA
#undef A2_QKSM
#undef A2_PV
    if (hi == 0) li_l[r32] = l_reg; asm volatile("s_waitcnt lgkmcnt(0)" ::: "memory");
    unsigned obase = (unsigned)((wid * QBLK + 4 * hi) * 256 + r32) * 4u;
    asm volatile("" : "+v"(obase));
    char* Ob = (char*)b.O;
#pragma unroll
    for (int r = 0; r < 16; ++r) { const float rl = __builtin_amdgcn_rcpf(li_l[att::crow(r, hi)]); const unsigned roff = obase + (unsigned)((r & 3) + 8 * (r >> 2)) * 1024u;
#pragma unroll
        for (int d0 = 0; d0 < 8; ++d0) *(float*)(Ob + roff + d0 * 128) = o[d0][r] * rl; }
    asm volatile("s_waitcnt lgkmcnt(0)" ::: "memory");
}
#undef A2_WAIT_BAR
}
#undef SBAR

constexpr int NWAVES = 8;
#ifndef MK_ONE_LAUNCH
#define MK_ONE_LAUNCH 1
#endif
constexpr int N_PHASES = 10;

constexpr int MI8_TILES = 40;
constexpr float W8_CLIP_SIGMAS = 4.0f;
constexpr int NBF = 10240, NG8 = 8192;
constexpr int S = 8192, DM = 4096, NIN = 18432, DFF = 16384, NHEAD = 8, AW = 2048, SGW = 2048, NGRP = 8, CHUNK = 128;
constexpr float LN_EPS = 1e-5f;
constexpr float ALPHA = 1.189207115002721f;
constexpr float LAMBDA_INIT = 0.2f;

constexpr size_t MiB = 1u << 20;
constexpr size_t WS_CTL = 0, CTL_ZERO_BYTES = 64 * 1024;
constexpr size_t WS_ROPE = 1 * MiB;
constexpr size_t WS_RS = 3 * MiB;
constexpr size_t WS_STATS = 2 * MiB;
constexpr size_t WS_WIN_T = 4 * MiB;
constexpr size_t WS_OPART = WS_WIN_T;
constexpr size_t WS_H1B = WS_WIN_T;
constexpr size_t WS_WPA_T = 148 * MiB, WS_WPS_T = 164 * MiB;
constexpr size_t WS_WOUT_T = 180 * MiB;
constexpr size_t WS_WMI_T = 212 * MiB;
constexpr size_t WS_WMO_T = 340 * MiB;
constexpr size_t WS_XB = 468 * MiB;
constexpr size_t WS_YA = WS_XB, WS_YB = WS_XB + 32 * MiB;
constexpr size_t WS_Q = 532 * MiB, WS_K = 564 * MiB, WS_V = 596 * MiB;
constexpr size_t WS_MERGED = WS_Q;
constexpr size_t WS_GU = 628 * MiB, WS_GS = 660 * MiB;
constexpr size_t WS_SGA = 692 * MiB, WS_SGB = 756 * MiB;
constexpr size_t WS_R1 = WS_SGA;
constexpr size_t WS_R2 = WS_SGB;
constexpr size_t WS_Z = 820 * MiB;
constexpr size_t WS_XF8 = WS_Z;
constexpr size_t WS_WG8_T = WS_Z + 32 * MiB;
constexpr size_t WS_END = 1076 * MiB;
static_assert((size_t)MI8_TILES * 256 * 4096 <= (size_t)MI8_TILES * 256 * 4096 * 2, "int8 rows of w_mlp_in^T fit in the head of the bf16 copy");
static_assert(WS_K == WS_Q + 32 * MiB && WS_V == WS_K + 32 * MiB && WS_GS == WS_GU + 32 * MiB && WS_SGB == WS_SGA + 64 * MiB, "EpiProj's section strides");
constexpr int CW_BAR = 1024;

constexpr int RING_OFF = 0, RING_BYTES = 131072;
constexpr int LDSCTL_OFF = RING_BYTES, MISC_OFF = LDSCTL_OFF + 320;
constexpr int LDS_BYTES = 147456;
static_assert(MISC_OFF + 128 <= LDS_BYTES && MISC_OFF + 128 <= att2::WSF_OFF && att2::LDS_NEED <= LDS_BYTES, "LDS map");

#define GAS __attribute__((address_space(1)))
#define LAS __attribute__((address_space(3)))
typedef unsigned short bf16;
typedef unsigned v4u __attribute__((ext_vector_type(4)));
typedef unsigned v2u __attribute__((ext_vector_type(2)));
typedef float f32x4 __attribute__((ext_vector_type(4)));
typedef float f32x2 __attribute__((ext_vector_type(2)));
typedef float f32x16 __attribute__((ext_vector_type(16)));
typedef short bf16x8 __attribute__((ext_vector_type(8)));
typedef GAS unsigned gu32;
#define RLX_AGENT __ATOMIC_RELAXED, __HIP_MEMORY_SCOPE_AGENT
#define LDS_WAIT() asm volatile("s_waitcnt lgkmcnt(0)" ::: "memory")
#define VM_WAIT() asm volatile("s_waitcnt vmcnt(0)" ::: "memory")
__device__ __forceinline__ unsigned pk2(float lo, float hi) { return pg8::cvt_pk_bf16(lo, hi); }
__device__ __forceinline__ float bflo(unsigned w) { return __uint_as_float(w << 16); }
__device__ __forceinline__ float bfhi(unsigned w) { return __uint_as_float(w & 0xffff0000u); }

#define XB_TMO      128
#define XB_XCNT(j)  (256  + 64 * (j))
#define XB_XSUB(j)  (1280 + 64 * (j))
#define XB_XGEN(j)  (2304 + 64 * (j))
#define XB_TOP      3328
#define XB_TOPGEN   3392
#define XCD_BAR_WORDS 3456
#define XB_SPIN_CAP (1u << 18)

__device__ __forceinline__ unsigned xb_ld(unsigned* p)              { return __hip_atomic_load(p, __ATOMIC_RELAXED, __HIP_MEMORY_SCOPE_AGENT); }
__device__ __forceinline__ unsigned xb_add(unsigned* p, unsigned v) { return __hip_atomic_fetch_add(p, v, __ATOMIC_RELAXED, __HIP_MEMORY_SCOPE_AGENT); }
__device__ __forceinline__ unsigned xb_xcc_id() { return (unsigned)__builtin_amdgcn_s_getreg((3 << 11) | 20) & 0xFu; }
#define XB_SPIN(cond, bar) do { unsigned _sp = 0; while (cond) { __builtin_amdgcn_s_sleep(1); \
    if ((++_sp & 255u) == 0u) { if (xb_ld(&(bar)[XB_TMO])) break; if (_sp > XB_SPIN_CAP) { atomicAdd(&(bar)[XB_TMO], 1u); break; } } } } while (0)

struct XcdBarrier {
    unsigned* bar; unsigned x;
    volatile LAS unsigned* st;
};

__device__ __forceinline__ XcdBarrier xcd_barrier_post(unsigned* bar, volatile LAS unsigned* st) {
    XcdBarrier b; b.bar = bar; b.x = xb_xcc_id(); b.st = st;
    if (threadIdx.x == 0) (void)xb_add(&bar[XB_XCNT(b.x)], 1u);
    return b;
}
__device__ __forceinline__ void xcd_barrier_complete(unsigned* bar, unsigned x, unsigned& nloc, unsigned& nx) {
    const unsigned G = gridDim.x * gridDim.y * gridDim.z;
    unsigned sum, cnt, mine, sp = 0u;
    for (;;) {
        sum = 0u; cnt = 0u; mine = 0u;
#pragma unroll
        for (unsigned j = 0; j < 16; ++j) { const unsigned c = xb_ld(&bar[XB_XCNT(j)]); sum += c; cnt += (c > 0u) ? 1u : 0u; mine = (j == x) ? c : mine; }
        if (sum == G) break;
        __builtin_amdgcn_s_sleep(1);
        if ((++sp & 255u) == 0u) { if (xb_ld(&bar[XB_TMO])) break; if (sp > XB_SPIN_CAP) { atomicAdd(&bar[XB_TMO], 1u); break; } }
    }
    nloc = mine > 0u ? mine : 1u; nx = cnt > 0u ? cnt : 1u;
}

__device__ __forceinline__ void xcd_barrier(const XcdBarrier& b) {
    asm volatile("s_waitcnt vmcnt(0)" ::: "memory");
    __syncthreads();
    if (threadIdx.x == 0) {
        unsigned* bar = b.bar;
        __builtin_amdgcn_s_waitcnt(0);
        unsigned nloc = b.st[0], nx = b.st[1];
        if (nloc == 0u) { xcd_barrier_complete(bar, b.x, nloc, nx); b.st[0] = nloc; b.st[1] = nx; }
        const unsigned old = xb_add(&bar[XB_XSUB(b.x)], 1u);
        const unsigned gen = old / nloc;
        if (old + 1u == (gen + 1u) * nloc) {
            __builtin_amdgcn_fence(__ATOMIC_RELEASE, "agent");
            asm volatile("s_waitcnt vmcnt(0)" ::: "memory");
            const unsigned og = xb_add(&bar[XB_TOP], 1u);
            const unsigned tg = og / nx;
            if (og + 1u == (tg + 1u) * nx) xb_add(&bar[XB_TOPGEN], 1u);
            else XB_SPIN(xb_ld(&bar[XB_TOPGEN]) == tg, bar);
            __builtin_amdgcn_fence(__ATOMIC_ACQUIRE, "agent");
            xb_add(&bar[XB_XGEN(b.x)], 1u);
            asm volatile("s_waitcnt vmcnt(0)" ::: "memory");
        } else {
            XB_SPIN(xb_ld(&bar[XB_XGEN(b.x)]) == gen, bar);
            __builtin_amdgcn_fence(__ATOMIC_ACQUIRE, "agent");
            asm volatile("s_waitcnt vmcnt(0)" ::: "memory");
        }
    }
    __syncthreads();
}


__device__ __forceinline__ float wave_sum(float v) {
#pragma unroll
    for (int o = 1; o < 64; o <<= 1) v += __shfl_xor(v, o);
    return v;
}
template <bool NT> __device__ __forceinline__ void p0_transpose_item(const float* W, int K, int N, bf16* WT, LAS float* scr, int item, int lane, int ldt = 0) {
    const int nblk = N / 32, kb = item / nblk, nb = item % nblk, k0 = 64 * kb, n0 = 32 * nb;
    float tmp[32];
#pragma unroll
    for (int i = 0; i < 32; ++i) { const int kk = 2 * i + (lane >> 5); tmp[i] = __builtin_nontemporal_load(&W[(size_t)(k0 + kk) * N + n0 + (lane & 31)]); }
#pragma unroll
    for (int i = 0; i < 32; ++i) { const int kk = 2 * i + (lane >> 5); scr[kk * 33 + (lane & 31)] = tmp[i]; }
    LDS_WAIT(); asm volatile("" ::: "memory");
    const int c = lane & 7;
#pragma unroll
    for (int j = 0; j < 4; ++j) { const int n = (lane >> 3) + 8 * j; const LAS float* s = scr + (8 * c) * 33 + n;
        v4u o; o.x = pk2(s[0 * 33], s[1 * 33]); o.y = pk2(s[2 * 33], s[3 * 33]); o.z = pk2(s[4 * 33], s[5 * 33]); o.w = pk2(s[6 * 33], s[7 * 33]);
        const size_t wo = (size_t)(n0 + n) * (ldt ? ldt : K) + k0 + 8 * c;
        if (NT) __builtin_nontemporal_store(o, (GAS v4u*)(WT + wo)); else *(GAS v4u*)(WT + wo) = o; }
    LDS_WAIT(); asm volatile("" ::: "memory");
}
__device__ __forceinline__ unsigned pk4_fp8(float a, float b, float c, float d) {
    a = fminf(fmaxf(a, -448.f), 448.f); b = fminf(fmaxf(b, -448.f), 448.f); c = fminf(fmaxf(c, -448.f), 448.f); d = fminf(fmaxf(d, -448.f), 448.f);
    int w = 0; w = __builtin_amdgcn_cvt_pk_fp8_f32(a, b, w, false); w = __builtin_amdgcn_cvt_pk_fp8_f32(c, d, w, true); return (unsigned)w; }
__device__ __forceinline__ void p0_transpose_item_f8(const float* W, int K, int N, int n0, int n0_out, int k0, unsigned char* WT, float scale, LAS float* scr, int lane) {
    float tmp[32];
#pragma unroll
    for (int i = 0; i < 32; ++i) { const int kk = 2 * i + (lane >> 5); tmp[i] = __builtin_nontemporal_load(&W[(size_t)(k0 + kk) * N + n0 + (lane & 31)]); }
#pragma unroll
    for (int i = 0; i < 32; ++i) { const int kk = 2 * i + (lane >> 5); scr[kk * 33 + (lane & 31)] = tmp[i]; }
    LDS_WAIT(); asm volatile("" ::: "memory");
    const int c = lane & 3;
#pragma unroll
    for (int j = 0; j < 2; ++j) { const int n = (lane >> 2) + 16 * j; const LAS float* s = scr + (16 * c) * 33 + n;
        v4u o; o.x = pk4_fp8(s[0 * 33] * scale, s[1 * 33] * scale, s[2 * 33] * scale, s[3 * 33] * scale); o.y = pk4_fp8(s[4 * 33] * scale, s[5 * 33] * scale, s[6 * 33] * scale, s[7 * 33] * scale);
        o.z = pk4_fp8(s[8 * 33] * scale, s[9 * 33] * scale, s[10 * 33] * scale, s[11 * 33] * scale); o.w = pk4_fp8(s[12 * 33] * scale, s[13 * 33] * scale, s[14 * 33] * scale, s[15 * 33] * scale);
        *(GAS v4u*)(WT + (size_t)(n0_out + n) * K + k0 + 16 * c) = o; }
    LDS_WAIT(); asm volatile("" ::: "memory");
}
__device__ __forceinline__ unsigned pk4_i8(float a, float b, float c, float d) {
    const int qa = (int)__builtin_rintf(fminf(fmaxf(a, -127.f), 127.f)), qb = (int)__builtin_rintf(fminf(fmaxf(b, -127.f), 127.f)), qc = (int)__builtin_rintf(fminf(fmaxf(c, -127.f), 127.f)), qd = (int)__builtin_rintf(fminf(fmaxf(d, -127.f), 127.f));
    return (unsigned)(qa & 0xff) | ((unsigned)(qb & 0xff) << 8) | ((unsigned)(qc & 0xff) << 16) | ((unsigned)qd << 24); }
__device__ __forceinline__ void p0_transpose_item_i8(const float* W, int K, int N, unsigned char* WT, float scale, LAS float* scr, int item, int lane) {
    const int nblk = N / 32, kb = item / nblk, nb = item % nblk, k0 = 64 * kb, n0 = 32 * nb;
    float tmp[32];
#pragma unroll
    for (int i = 0; i < 32; ++i) { const int kk = 2 * i + (lane >> 5); tmp[i] = __builtin_nontemporal_load(&W[(size_t)(k0 + kk) * N + n0 + (lane & 31)]); }
#pragma unroll
    for (int i = 0; i < 32; ++i) { const int kk = 2 * i + (lane >> 5); scr[kk * 33 + (lane & 31)] = tmp[i]; }
    LDS_WAIT(); asm volatile("" ::: "memory");
    const int c = lane & 3;
#pragma unroll
    for (int j = 0; j < 2; ++j) { const int n = (lane >> 2) + 16 * j; const LAS float* q = scr + (16 * c) * 33 + n;
        v4u o; o.x = pk4_i8(q[0 * 33] * scale, q[1 * 33] * scale, q[2 * 33] * scale, q[3 * 33] * scale); o.y = pk4_i8(q[4 * 33] * scale, q[5 * 33] * scale, q[6 * 33] * scale, q[7 * 33] * scale);
        o.z = pk4_i8(q[8 * 33] * scale, q[9 * 33] * scale, q[10 * 33] * scale, q[11 * 33] * scale); o.w = pk4_i8(q[12 * 33] * scale, q[13 * 33] * scale, q[14 * 33] * scale, q[15 * 33] * scale);
        *(GAS v4u*)(WT + (size_t)(n0 + n) * K + k0 + 16 * c) = o; }
    LDS_WAIT(); asm volatile("" ::: "memory");
}
__device__ __forceinline__ void ln_row_4096(const float* xrow, float* orow, bf16* obrow, const float* g, const float* b, int lane) {
    const GAS f32x4* xr = (const GAS f32x4*)xrow + lane;
    f32x4 v[16]; float s = 0.f;
#pragma unroll
    for (int j = 0; j < 16; ++j) { v[j] = xr[64 * j]; s += (v[j].x + v[j].y) + (v[j].z + v[j].w); }
    const float mean = wave_sum(s) * (1.f / 4096.f); float s2 = 0.f;
#pragma unroll
    for (int j = 0; j < 16; ++j) { v[j] = v[j] - mean; s2 += (v[j].x * v[j].x + v[j].y * v[j].y) + (v[j].z * v[j].z + v[j].w * v[j].w); }
    const float rstd = 1.f / sqrtf(wave_sum(s2) * (1.f / 4096.f) + LN_EPS);
#pragma unroll
    for (int j = 0; j < 16; ++j) { const int c4 = 64 * j + lane; const f32x4 gg = ((const GAS f32x4*)g)[c4], bb = ((const GAS f32x4*)b)[c4];
        const f32x4 y = v[j] * rstd * gg + bb;
        ((GAS f32x4*)orow)[c4] = y;
        if (obrow) { v2u w; w.x = pk2(y.x, y.y); w.y = pk2(y.z, y.w); ((GAS v2u*)obrow)[c4] = w; } }
}

__device__ __forceinline__ void ln_row_4096_b(const bf16* xrow, float* orow, bf16* obrow, const float* g, const float* b, int lane) {
    const GAS v4u* xr = (const GAS v4u*)xrow + lane;
    float v[64]; float s = 0.f;
#pragma unroll
    for (int j = 0; j < 8; ++j) { const v4u w = xr[64 * j];
        v[8 * j + 0] = bflo(w.x); v[8 * j + 1] = bfhi(w.x); v[8 * j + 2] = bflo(w.y); v[8 * j + 3] = bfhi(w.y);
        v[8 * j + 4] = bflo(w.z); v[8 * j + 5] = bfhi(w.z); v[8 * j + 6] = bflo(w.w); v[8 * j + 7] = bfhi(w.w); }
#pragma unroll
    for (int e = 0; e < 64; ++e) s += v[e];
    const float mean = wave_sum(s) * (1.f / 4096.f); float s2 = 0.f;
#pragma unroll
    for (int e = 0; e < 64; ++e) { v[e] -= mean; s2 += v[e] * v[e]; }
    const float rstd = 1.f / sqrtf(wave_sum(s2) * (1.f / 4096.f) + LN_EPS);
#pragma unroll
    for (int j = 0; j < 8; ++j) { const int c8 = 64 * j + lane;
        const f32x4 g0 = ((const GAS f32x4*)g)[2 * c8], g1 = ((const GAS f32x4*)g)[2 * c8 + 1], b0 = ((const GAS f32x4*)b)[2 * c8], b1 = ((const GAS f32x4*)b)[2 * c8 + 1];
        const f32x4 y0 = (f32x4){v[8 * j + 0], v[8 * j + 1], v[8 * j + 2], v[8 * j + 3]} * rstd * g0 + b0, y1 = (f32x4){v[8 * j + 4], v[8 * j + 5], v[8 * j + 6], v[8 * j + 7]} * rstd * g1 + b1;
        if (obrow) ((GAS v4u*)obrow)[c8] = pg8::pack8(y0, y1);
        else { ((GAS f32x4*)orow)[2 * c8] = y0; ((GAS f32x4*)orow)[2 * c8 + 1] = y1; } }
}

__device__ __forceinline__ void ln_row_4096_bf(const bf16* xrow, float* orow, const float* g, const float* b, int lane) {
    const GAS v2u* xr = (const GAS v2u*)xrow + lane;
    f32x4 v[16]; float s = 0.f;
#pragma unroll
    for (int j = 0; j < 16; ++j) { const v2u w = xr[64 * j]; v[j] = (f32x4){bflo(w.x), bfhi(w.x), bflo(w.y), bfhi(w.y)}; s += (v[j].x + v[j].y) + (v[j].z + v[j].w); }
    const float mean = wave_sum(s) * (1.f / 4096.f); float s2 = 0.f;
#pragma unroll
    for (int j = 0; j < 16; ++j) { v[j] = v[j] - mean; s2 += (v[j].x * v[j].x + v[j].y * v[j].y) + (v[j].z * v[j].z + v[j].w * v[j].w); }
    const float rstd = 1.f / sqrtf(wave_sum(s2) * (1.f / 4096.f) + LN_EPS);
#pragma unroll
    for (int j = 0; j < 16; ++j) { const int c4 = 64 * j + lane; const f32x4 gg = ((const GAS f32x4*)g)[c4], bb = ((const GAS f32x4*)b)[c4];
        ((GAS f32x4*)orow)[c4] = v[j] * rstd * gg + bb; }
}

__device__ __forceinline__ float t8scale(const float* W, int lane) {
    float q = 0.f;
#pragma unroll
    for (int j = 0; j < 16; ++j) { const f32x4 v = ((const GAS f32x4*)W)[64 * j + lane]; q += (v.x * v.x + v.y * v.y) + (v.z * v.z + v.w * v.w); }
    q = wave_sum(q); return 127.0f / (W8_CLIP_SIGMAS * sqrtf(q * (1.0f / 4096.f)) + 1e-30f);
}
__device__ __forceinline__ void ln_row_4096_b8(const bf16* xrow, bf16* obrow, unsigned char* o8row, float* hs, float wscale, const float* g, const float* b, int lane) {
    const GAS v4u* xr = (const GAS v4u*)xrow + lane;
    float v[64]; float s = 0.f;
#pragma unroll
    for (int j = 0; j < 8; ++j) { const v4u w = xr[64 * j];
        v[8 * j + 0] = bflo(w.x); v[8 * j + 1] = bfhi(w.x); v[8 * j + 2] = bflo(w.y); v[8 * j + 3] = bfhi(w.y);
        v[8 * j + 4] = bflo(w.z); v[8 * j + 5] = bfhi(w.z); v[8 * j + 6] = bflo(w.w); v[8 * j + 7] = bfhi(w.w); }
#pragma unroll
    for (int e = 0; e < 64; ++e) s += v[e];
    const float mean = wave_sum(s) * (1.f / 4096.f); float s2 = 0.f;
#pragma unroll
    for (int e = 0; e < 64; ++e) { v[e] -= mean; s2 += v[e] * v[e]; }
    const float rstd = 1.f / sqrtf(wave_sum(s2) * (1.f / 4096.f) + LN_EPS);
    float am = 0.f;
#pragma unroll
    for (int j = 0; j < 8; ++j) { const int c8 = 64 * j + lane;
        const f32x4 g0 = ((const GAS f32x4*)g)[2 * c8], g1 = ((const GAS f32x4*)g)[2 * c8 + 1], b0 = ((const GAS f32x4*)b)[2 * c8], b1 = ((const GAS f32x4*)b)[2 * c8 + 1];
        const f32x4 y0 = (f32x4){v[8 * j + 0], v[8 * j + 1], v[8 * j + 2], v[8 * j + 3]} * rstd * g0 + b0, y1 = (f32x4){v[8 * j + 4], v[8 * j + 5], v[8 * j + 6], v[8 * j + 7]} * rstd * g1 + b1;
        ((GAS v4u*)obrow)[c8] = pg8::pack8(y0, y1);
        v[8 * j + 0] = y0.x; v[8 * j + 1] = y0.y; v[8 * j + 2] = y0.z; v[8 * j + 3] = y0.w; v[8 * j + 4] = y1.x; v[8 * j + 5] = y1.y; v[8 * j + 6] = y1.z; v[8 * j + 7] = y1.w;
        am = fmaxf(am, fmaxf(fmaxf(fmaxf(fabsf(y0.x), fabsf(y0.y)), fmaxf(fabsf(y0.z), fabsf(y0.w))), fmaxf(fmaxf(fabsf(y1.x), fabsf(y1.y)), fmaxf(fabsf(y1.z), fabsf(y1.w))))); }
#pragma unroll
    for (int o = 1; o < 64; o <<= 1) am = fmaxf(am, __shfl_xor(am, o));
    const float inv = am > 0.f ? 127.0f / am : 0.f;
#pragma unroll
    for (int j = 0; j < 8; ++j) { v2u o8; o8.x = pk4_i8(v[8 * j + 0] * inv, v[8 * j + 1] * inv, v[8 * j + 2] * inv, v[8 * j + 3] * inv); o8.y = pk4_i8(v[8 * j + 4] * inv, v[8 * j + 5] * inv, v[8 * j + 6] * inv, v[8 * j + 7] * inv);
        ((GAS v2u*)o8row)[64 * j + lane] = o8; }
    if (lane == 0) *hs = am * (1.0f / 127.0f) / wscale;
}

__device__ __forceinline__ void sgu_item(char* lds, int c, int g, const bf16* GS, const bf16* GU, const float* stats, const float* ln_g, const float* ln_b,
                                         const float* w_sp, const float* b_sp, bf16* YB) {
    const int tid = threadIdx.x, wid = __builtin_amdgcn_readfirstlane(tid >> 6), lane = tid & 63, r32 = lane & 31, hi = lane >> 5;
    const int sr = tid >> 4, sc = (tid & 15) * 8;
#pragma unroll
    for (int dh = 0; dh < 2; ++dh) {
        const int col = g * 256 + dh * 128 + sc;
        const f32x4 g0 = *(const f32x4*)(ln_g + col), g1 = *(const f32x4*)(ln_g + col + 4), b0 = *(const f32x4*)(ln_b + col), b1 = *(const f32x4*)(ln_b + col + 4);
#pragma unroll
        for (int st = 0; st < 2; ++st)
#pragma unroll
            for (int hf = 0; hf < 2; ++hf) {
                const int k = hf * 32 + sr, grow = c * CHUNK + st * 64 + k;
                const v4u raw = *(const v4u*)(GS + (size_t)grow * SGW + col);
                const f32x2 ms = *(const f32x2*)(stats + 2 * grow);
                f32x4 x0 = {bflo(raw.x), bfhi(raw.x), bflo(raw.y), bfhi(raw.y)}, x1 = {bflo(raw.z), bfhi(raw.z), bflo(raw.w), bfhi(raw.w)};
                x0 = (x0 - ms.x) * ms.y * g0 + b0; x1 = (x1 - ms.x) * ms.y * g1 + b1;
                *(v4u*)(lds + (st * 2 + dh) * 16384 + att::v_st(k, sc)) = pg8::pack8(x0, x1);
            }
    }
    __syncthreads();
    const int tb = wid & 3, dh = wid >> 2;
    f32x16 o[4] = {};
    const int vb0 = (int)(uintptr_t)lds + att::v_rd_base(lane);
#pragma unroll
    for (int st = 0; st < 2; ++st) {
        bf16x8 pa[4];
#pragma unroll
        for (int ks = 0; ks < 4; ++ks) { const int t = tb * 32 + r32, s0 = st * 64 + ks * 16 + 8 * hi;
            const float* wp = w_sp + ((size_t)g * CHUNK + t) * CHUNK + s0;
            f32x4 a = *(const f32x4*)wp, b = *(const f32x4*)(wp + 4);
#pragma unroll
            for (int e = 0; e < 4; ++e) { if (s0 + e > t) a[e] = 0.f; if (s0 + 4 + e > t) b[e] = 0.f; }
            const v4u w = pg8::pack8(a, b); pa[ks] = __builtin_bit_cast(bf16x8, w); }
        att::pv_tile<0, false>(o, vb0 + (st * 2 + dh) * 16384, pa[0], pa[1], pa[2], pa[3], true);
    }
    __syncthreads();
    { unsigned short* img = (unsigned short*)lds;
#pragma unroll
      for (int r = 0; r < 16; ++r) { const int t = tb * 32 + att::crow(r, hi); const float bs = b_sp[g * CHUNK + t];
#pragma unroll
          for (int d0 = 0; d0 < 4; ++d0) img[t * 256 + dh * 128 + d0 * 32 + r32] = (unsigned short)(pk2(o[d0][r] + bs, 0.f) & 0xffffu); }
      __syncthreads();
#pragma unroll
      for (int i = 0; i < 8; ++i) { const int pc = i * 512 + tid, t = pc >> 5, d8 = (pc & 31) * 8;
          const v4u m = *(const v4u*)(img + t * 256 + d8);
          const size_t go = (size_t)(c * CHUNK + t) * SGW + g * 256 + d8;
          const v4u u = *(const v4u*)(GU + go);
          const f32x4 y0 = {bflo(u.x) * bflo(m.x), bfhi(u.x) * bfhi(m.x), bflo(u.y) * bflo(m.y), bfhi(u.y) * bfhi(m.y)}, y1 = {bflo(u.z) * bflo(m.z), bfhi(u.z) * bfhi(m.z), bflo(u.w) * bflo(m.w), bfhi(u.w) * bfhi(m.w)};
          *(v4u*)(YB + (size_t)(c * CHUNK + t) * 4096 + 2048 + g * 256 + d8) = pg8::pack8(y0, y1); } }
    __syncthreads();
}


__device__ __forceinline__ att::BlockRef<att::bf16, float> att_ref(const att::SwaItem& it, int pass, const bf16* QH, const bf16* KH, const bf16* VH, float* OPART) {
    const int qb = pass ? it.qb1 : it.qb0, h = it.bh & 7, vh = (it.bh >> 3) & 1, c = it.bh >> 4;
    att::BlockRef<att::bf16, float> r;
    r.Q = (const att::bf16*)QH + ((size_t)(h * 2 + c) * S + (size_t)qb * att::QB) * 128;
    r.K = (const att::bf16*)KH + (size_t)(h * 2 + c) * S * 128;
    r.V = (const att::bf16*)VH + (size_t)(h * 2 + vh) * S * 128;
    r.O = OPART + ((size_t)((h * 2 + c) * 2 + vh) * S + (size_t)qb * att::QB) * 128;
    r.P0 = qb * att::QB; return r;
}

struct Args { const float* in[22]; float* out; unsigned char* ws; int ph_lo, ph_hi; };
__global__ void __launch_bounds__(NWAVES * 64, 2) mk_fwd(Args args) {
    extern __shared__ __attribute__((aligned(16))) unsigned char lds[];
    LAS unsigned char* const ldsl = (LAS unsigned char*)lds;
    volatile LAS unsigned* const MISC = (volatile LAS unsigned*)(ldsl + MISC_OFF);
    const int tid = threadIdx.x, lane = tid & 63, wave = __builtin_amdgcn_readfirstlane(tid >> 6);
    const int G = gridDim.x; const int bx = blockIdx.x; const int vcu = (G % 8 == 0) ? (bx % 8) * (G / 8) + bx / 8 : bx;
    const int gw = vcu * NWAVES + wave, NGW = G * NWAVES;
    unsigned char* const ws = args.ws;
    gu32* const ctl = (gu32*)(ws + WS_CTL);
    const float* x = args.in[0]; const float* w_in = args.in[1];
    const float* lq1 = args.in[2]; const float* lk1 = args.in[3]; const float* lq2 = args.in[4]; const float* lk2 = args.in[5];
    const float* subln_w = args.in[6]; const float* sgu_ln_g = args.in[7]; const float* sgu_ln_b = args.in[8];
    const float* w_spatial = args.in[9]; const float* b_spatial = args.in[10];
    const float* w_pa = args.in[11]; const float* w_ps = args.in[12]; const float* w_out = args.in[13];
    const float* ln1_g = args.in[14]; const float* ln1_b = args.in[15];
    const float* w_mi = args.in[16]; const float* b_mi = args.in[17]; const float* w_mo = args.in[18]; const float* b_mo = args.in[19];
    const float* ln2_g = args.in[20]; const float* ln2_b = args.in[21];
    float* const out = args.out;
    float* const rope = (float*)(ws + WS_ROPE); float* const stats = (float*)(ws + WS_STATS);
    bf16* const WIN_T = (bf16*)(ws + WS_WIN_T); float* const OPART = (float*)(ws + WS_OPART); bf16* const H1B = (bf16*)(ws + WS_H1B);
    bf16* const WPA_T = (bf16*)(ws + WS_WPA_T); bf16* const WPS_T = (bf16*)(ws + WS_WPS_T); bf16* const WOUT_T = (bf16*)(ws + WS_WOUT_T);
    bf16* const WMI_T = (bf16*)(ws + WS_WMI_T); bf16* const WMO_T = (bf16*)(ws + WS_WMO_T);
    bf16* const XB = (bf16*)(ws + WS_XB); bf16* const YA = (bf16*)(ws + WS_YA); bf16* const YB = (bf16*)(ws + WS_YB);
    bf16* const QH = (bf16*)(ws + WS_Q); bf16* const KH = (bf16*)(ws + WS_K); bf16* const VH = (bf16*)(ws + WS_V); bf16* const MERGED = (bf16*)(ws + WS_MERGED);
    bf16* const GU = (bf16*)(ws + WS_GU); bf16* const GS = (bf16*)(ws + WS_GS); bf16* const SGA = (bf16*)(ws + WS_SGA); bf16* const SGB = (bf16*)(ws + WS_SGB);
    bf16* const R1 = (bf16*)(ws + WS_R1); bf16* const R2 = (bf16*)(ws + WS_R2); bf16* const Z = (bf16*)(ws + WS_Z);
    unsigned char* const X8 = ws + WS_XB; unsigned char* const WIN8_T = ws + WS_WIN_T; float* const rsc = (float*)(ws + WS_RS); float* const h1s = (float*)(ws + WS_RS + 32768);
    unsigned char* const H18 = ws + WS_XB; unsigned char* const WMI8_T = ws + WS_WMI_T;

    for (int u = tid; u < (LDS_BYTES - LDSCTL_OFF) / 4; u += NWAVES * 64) ((LAS unsigned*)(ldsl + LDSCTL_OFF))[u] = 0u;
    __syncthreads();
    XcdBarrier bar; bar.bar = (unsigned*)(ctl + CW_BAR); bar.x = 0; bar.st = nullptr;
    if (MK_ONE_LAUNCH) bar = xcd_barrier_post((unsigned*)(ctl + CW_BAR), MISC + 8);
#define GRID_BAR() do { if (MK_ONE_LAUNCH) xcd_barrier(bar); } while (0)
    const int lo = args.ph_lo, hi = args.ph_hi;
#define IN(k) (lo <= (k) && (k) < hi)
#define BOTH(k) (IN(k) && IN((k) + 1))

    if (IN(0)) {
        LAS float* scr = (LAS float*)(ldsl + RING_OFF + wave * 16384);
        float w8s; { float q = 0.f;
#pragma unroll
            for (int j = 0; j < 16; ++j) { const f32x4 v = ((const GAS f32x4*)w_in)[64 * j + lane]; q += (v.x * v.x + v.y * v.y) + (v.z * v.z + v.w * v.w); }
            q = wave_sum(q); w8s = 127.0f / (W8_CLIP_SIGMAS * sqrtf(q * (1.0f / 4096.f)) + 1e-30f); }
        const float wmi8s = t8scale(w_mi, lane);
        constexpr int I_IN = (DM / 64) * (NIN / 32), I_PA = (AW / 64) * (DM / 32), I_PS = (SGW / 64) * (DM / 32), I_OUT = (DM / 64) * (DM / 32),
                      I_MI = (DM / 64) * (DFF / 32), I_MO = (DFF / 64) * (DM / 32);
        constexpr int NITEMS = I_IN + I_PA + I_PS + I_OUT + I_MI + I_MO;
        for (int it = gw; it < NITEMS; it += NGW) {
            int r = NITEMS - 1 - it;
            if (r < I_IN) { p0_transpose_item_i8(w_in, DM, NIN, WIN8_T, w8s, scr, r, lane); continue; } r -= I_IN;
            if (r < I_PA) { p0_transpose_item<true>(w_pa, AW, DM, WPA_T, scr, r, lane, 4096); continue; } r -= I_PA;
            if (r < I_PS) { p0_transpose_item<true>(w_ps, SGW, DM, WPA_T + 2048, scr, r, lane, 4096); continue; } r -= I_PS;
            if (r < I_OUT) { p0_transpose_item<true>(w_out, DM, DM, WOUT_T, scr, r, lane); continue; } r -= I_OUT;
            if (r < I_MI) { const int nb = r % (DFF / 32);
                if (nb < MI8_TILES * 8) p0_transpose_item_i8(w_mi, DM, DFF, WMI8_T, wmi8s, scr, r, lane);
                else p0_transpose_item<true>(w_mi, DM, DFF, WMI_T, scr, r, lane);
                continue; } r -= I_MI;
            p0_transpose_item<true>(w_mo, DFF, DM, WMO_T, scr, r, lane);
        }
        {
            for (int row = gw; row < S; row += NGW) { const GAS f32x4* xr = (const GAS f32x4*)(x + (size_t)row * DM) + lane; f32x4 v[16]; float am = 0.f;
#pragma unroll
                for (int j = 0; j < 16; ++j) { v[j] = __builtin_nontemporal_load(&xr[64 * j]); am = fmaxf(fmaxf(am, fmaxf(fabsf(v[j].x), fabsf(v[j].y))), fmaxf(fabsf(v[j].z), fabsf(v[j].w))); }
#pragma unroll
                for (int o = 1; o < 64; o <<= 1) am = fmaxf(am, __shfl_xor(am, o));
                const float inv = am > 0.f ? 127.0f / am : 0.f;
#pragma unroll
                for (int j = 0; j < 16; ++j) ((GAS unsigned*)(X8 + (size_t)row * DM))[64 * j + lane] = pk4_i8(v[j].x * inv, v[j].y * inv, v[j].z * inv, v[j].w * inv);
                if (lane == 0) rsc[row] = am * (1.0f / 127.0f) / w8s; }
        }
        {
            for (int i = gw * 64 + lane; i < S * 16; i += NGW * 64) { const int pos = i >> 4, j = i & 15;
                double f = 1.0; for (int q = 0; q < j; ++q) f *= 0.44036660267178046;
                const double rev = (double)pos * f * 0.15915494309189535; const float fr = (float)(rev - __builtin_floor(rev));
                f32x2 cs; cs.x = __builtin_amdgcn_cosf(fr); cs.y = __builtin_amdgcn_sinf(fr); ((GAS f32x2*)rope)[i] = cs; }
        }
        if (BOTH(0)) GRID_BAR();
    }

    if (IN(1)) {
        { pg8::Gemm g{(const bf16*)X8, (const bf16*)WIN8_T, S, NIN, DM}; pg8::StaticOrder so; so.init(S, NIN, G, bx);
          pg8::EpiProj E{QH, GU, SGA, rope, rsc};
          pg8::gemm_phase<pg8::EpiProj, pg8::StaticOrder, true, true, false, true>(ldsl + RING_OFF, g, so, E); }
        if (BOTH(1)) GRID_BAR();
    }

    if (IN(2)) {
        for (int row = gw; row < S; row += NGW) {
            const GAS v4u* p = (const GAS v4u*)(GS + (size_t)row * SGW) + lane; float v[32]; float s = 0.f;
#pragma unroll
            for (int j = 0; j < 4; ++j) { const v4u w = p[64 * j];
                v[8 * j + 0] = bflo(w.x); v[8 * j + 1] = bfhi(w.x); v[8 * j + 2] = bflo(w.y); v[8 * j + 3] = bfhi(w.y);
                v[8 * j + 4] = bflo(w.z); v[8 * j + 5] = bfhi(w.z); v[8 * j + 6] = bflo(w.w); v[8 * j + 7] = bfhi(w.w); }
#pragma unroll
            for (int e = 0; e < 32; ++e) s += v[e];
            const float mean = wave_sum(s) * (1.f / 2048.f); float q = 0.f;
#pragma unroll
            for (int e = 0; e < 32; ++e) { const float d = v[e] - mean; q += d * d; }
            const float rstd = 1.f / sqrtf(wave_sum(q) * (1.f / 2048.f) + LN_EPS);
            if (lane == 0) { f32x2 ms; ms.x = mean; ms.y = rstd; ((GAS f32x2*)stats)[row] = ms; }
        }
        {
            int vslot = 0;
            for (int item = bx; item < 256; item += G) { const int h = item & 7, c = (item >> 3) >> 4, y = (item >> 3) & 15;
                for (int pass = 0; pass < 2; ++pass) { const int qb = pass == 0 ? 31 - y : y;
                    att2::Blk b;
                    b.Q = (const att::bf16*)QH + ((size_t)(h * 2 + c) * S + (size_t)qb * 256) * 128;
                    b.K = (const att::bf16*)KH + (size_t)(h * 2 + c) * S * 128;
                    b.V = (const att::bf16*)VH + (size_t)(h * 2) * S * 128;
                    b.O = OPART + ((size_t)(h * 2 + c) * S + (size_t)qb * 256) * 256;
                    b.P0 = qb * 256;
                    att2::diff_attn_block(b, (size_t)S * 128, (char*)lds + RING_OFF, vslot); } }
        }
        if (BOTH(2)) GRID_BAR();
    }

    if (IN(3)) {
        float a1 = lq1[lane] * lk1[lane] + lq1[lane + 64] * lk1[lane + 64], a2 = lq2[lane] * lk2[lane] + lq2[lane + 64] * lk2[lane + 64];
        a1 = wave_sum(a1); a2 = wave_sum(a2);
        const float lam = __builtin_amdgcn_exp2f(a1 * 1.4426950408889634f) - __builtin_amdgcn_exp2f(a2 * 1.4426950408889634f) + LAMBDA_INIT;
        const int d = lane * 4;
        const f32x4 sw = *(const f32x4*)(subln_w + d);
        for (int it0 = gw; it0 < S * NHEAD; it0 += 4 * NGW) { f32x4 o0[4], o1[4];
#pragma unroll
            for (int u = 0; u < 4; ++u) { const int it = it0 + u * NGW, t = it >> 3, h = it & 7;
                if (it < S * NHEAD) { o0[u] = *(const GAS f32x4*)(OPART + ((size_t)(h * 2 + 0) * S + t) * 256 + d);
                                      o1[u] = *(const GAS f32x4*)(OPART + ((size_t)(h * 2 + 1) * S + t) * 256 + d); }
                else { o0[u] = (f32x4){0.f, 0.f, 0.f, 0.f}; o1[u] = o0[u]; } }
#pragma unroll
            for (int u = 0; u < 4; ++u) { const int it = it0 + u * NGW, t = it >> 3, h = it & 7;
                const f32x4 df = o0[u] - lam * o1[u];
                const float ss = wave_sum((df.x * df.x + df.y * df.y) + (df.z * df.z + df.w * df.w));
                const float r = (1.0f - LAMBDA_INIT) / sqrtf(ss * (1.f / 256.f) + LN_EPS);
                const f32x4 y = df * r * sw; v2u w; w.x = pk2(y.x, y.y); w.y = pk2(y.z, y.w);
                if (it < S * NHEAD) *(GAS v2u*)(YA + (size_t)t * 4096 + h * 256 + d) = w; } }
        for (int it = vcu; it < (S / CHUNK) * NGRP; it += G) sgu_item((char*)lds + RING_OFF, it >> 3, it & 7, GS, GU, stats, sgu_ln_g, sgu_ln_b, w_spatial, b_spatial, YA);
        if (BOTH(3)) GRID_BAR();
    }

    if (IN(4)) {
        pg8::StaticOrder so; so.init(S, DM, G, bx);
        { pg8::Gemm g{YA, WPA_T, S, DM, 4096}; pg8::EpiGate2 E{SGA, SGB, MERGED}; pg8::gemm_phase<pg8::EpiGate2, pg8::StaticOrder, true, true>(ldsl + RING_OFF, g, so, E); }
        if (BOTH(4)) GRID_BAR();
    }

    if (IN(5)) {
        pg8::Gemm g{MERGED, WOUT_T, S, DM, DM}; pg8::StaticOrder so; so.init(S, DM, G, bx);
        pg8::EpiResB<false> E{x, R1, nullptr, ALPHA};
        pg8::gemm_phase<pg8::EpiResB<false>, pg8::StaticOrder, true, true>(ldsl + RING_OFF, g, so, E);
        if (BOTH(5)) GRID_BAR();
    }

    if (IN(6)) {
        { const float wmi8s = t8scale(w_mi, lane);
          for (int row = gw; row < S; row += NGW) ln_row_4096_b8(R1 + (size_t)row * DM, H1B + (size_t)row * DM, H18 + (size_t)row * DM, h1s + row, wmi8s, ln1_g, ln1_b, lane); }
        if (BOTH(6)) GRID_BAR();
    }

    if (IN(7)) {
        constexpr int N8 = MI8_TILES * 256;
        { pg8::Gemm g{(const bf16*)H18, (const bf16*)WMI8_T, S, N8, DM}; pg8::StaticOrder so; so.init(S, N8, G, bx);
          pg8::EpiRelu2<true> E{Z, DFF, b_mi, h1s};
          pg8::gemm_phase<pg8::EpiRelu2<true>, pg8::StaticOrder, true, true, false, true>(ldsl + RING_OFF, g, so, E); }
        { pg8::Gemm g{H1B, WMI_T + (size_t)N8 * DM, S, DFF - N8, DM}; pg8::StaticOrder so; so.init(S, DFF - N8, G, bx);
          pg8::EpiRelu2<false> E{Z + N8, DFF, b_mi + N8};
          pg8::gemm_phase<pg8::EpiRelu2<false>, pg8::StaticOrder, true, true>(ldsl + RING_OFF, g, so, E); }
        if (BOTH(7)) GRID_BAR();
    }

    if (IN(8)) {
        pg8::Gemm g{Z, WMO_T, S, DM, DFF}; pg8::StaticOrder so; so.init(S, DM, G, bx);
        pg8::EpiResB<true> E{H1B, R2, b_mo, ALPHA};
        pg8::gemm_phase<pg8::EpiResB<true>, pg8::StaticOrder, true, true>(ldsl + RING_OFF, g, so, E);
        if (BOTH(8)) GRID_BAR();
    }

    if (IN(9)) {
        for (int row = gw; row < S; row += NGW) ln_row_4096_bf(R2 + (size_t)row * DM, out + (size_t)row * DM, ln2_g, ln2_b, lane);
    }
#undef IN
#undef BOTH
#undef GRID_BAR
}

extern "C" void kernel_launch(void* const* d_in, const int* in_sizes, int n_in, void* d_out, int out_size, void* d_ws, size_t ws_size, hipStream_t stream) {
    static int grid = 0;
    if (grid == 0) {
        if (n_in != 22 || in_sizes[0] != S * DM || out_size != S * DM || ws_size < WS_END) { fprintf(stderr, "kernel_launch: built for 22 inputs, x/out of %d floats, >= %zu bytes of workspace; got n_in %d, in0 %d, out %d, ws %zu; nothing launched\n", S * DM, (size_t)WS_END, n_in, n_in > 0 ? in_sizes[0] : -1, out_size, ws_size); grid = -1; return; }
        int dev = 0, cus = 0, per_cu = 0;
        if (hipGetDevice(&dev) != hipSuccess || hipDeviceGetAttribute(&cus, hipDeviceAttributeMultiprocessorCount, dev) != hipSuccess) { fprintf(stderr, "kernel_launch: hipGetDevice / hipDeviceGetAttribute failed\n"); grid = -1; return; }
        if (hipFuncSetAttribute((const void*)mk_fwd, hipFuncAttributeMaxDynamicSharedMemorySize, LDS_BYTES) != hipSuccess) { fprintf(stderr, "kernel_launch: hipFuncSetAttribute failed\n"); grid = -1; return; }
        if (hipOccupancyMaxActiveBlocksPerMultiprocessor(&per_cu, (const void*)mk_fwd, NWAVES * 64, LDS_BYTES) != hipSuccess || per_cu < 1)
            fprintf(stderr, "kernel_launch: note: the occupancy query reports %d workgroups per CU\n", per_cu);
        (void)hipGetLastError();
        grid = cus;
    }
    if (grid < 0) return;
    if (hipMemsetAsync((char*)d_ws + WS_CTL, 0, CTL_ZERO_BYTES, stream) != hipSuccess) { fprintf(stderr, "kernel_launch: hipMemsetAsync failed\n"); return; }
    Args a{};
    for (int i = 0; i < 22; ++i) a.in[i] = (const float*)d_in[i];
    a.out = (float*)d_out; a.ws = (unsigned char*)d_ws;
#if MK_ONE_LAUNCH
    a.ph_lo = 0; a.ph_hi = N_PHASES;
    hipLaunchKernelGGL(mk_fwd, dim3(grid), dim3(NWAVES * 64), LDS_BYTES, stream, a);
#else
#ifndef PROBE_REP
#define PROBE_REP -1
#endif
    for (int p = 0; p < N_PHASES; ++p) { a.ph_lo = p; a.ph_hi = p + 1; for (int r = 0; r < (p == PROBE_REP ? 2 : 1); ++r) hipLaunchKernelGGL(mk_fwd, dim3(grid), dim3(NWAVES * 64), LDS_BYTES, stream, a); }
#endif
    const hipError_t le = hipPeekAtLastError();
    if (le != hipSuccess) fprintf(stderr, "kernel_launch: launch failed: %s\n", hipGetErrorName(le));
}
```

```cpp
#include <hip/hip_runtime.h>
#include <hip/hip_bf16.h>
#include <cstdio>
#include <cstdint>
namespace pg8 {
#define PG8_LAS __attribute__((address_space(3)))
typedef unsigned short bf16_t;
typedef short bf16x8 __attribute__((ext_vector_type(8)));
typedef float f32x4 __attribute__((ext_vector_type(4)));
typedef unsigned u32x4 __attribute__((ext_vector_type(4)));
typedef int i32x4 __attribute__((ext_vector_type(4)));
typedef int i32x8 __attribute__((ext_vector_type(8)));
constexpr int BM = 256, BK = 64, HALF = 128, HTB = HALF * BK * 2  , STAGE_BYTES = 8 * HTB, NXCD = 8, WGM = 8;

__host__ __device__ __forceinline__ int lds_byte(int r, int c) { const int st = (r >> 4) * 2 + (c >> 5), rr = r & 15, cc = c & 31, ob = rr * 64 + cc * 2; return st * 1024 + (ob ^ (((ob >> 9) & 1) << 5)); }
__host__ __device__ __forceinline__ void stage_rc(int b, int& R, int& C) { const int st = b / 1024, sb = b % 1024, swz = sb ^ (((sb >> 9) & 1) << 5); R = (st >> 1) * 16 + swz / 64; C = (st & 1) * 32 + (swz % 64) / 2; }
__host__ __device__ __forceinline__ int perm32(int rho) { const int n = rho >> 4, i = rho & 15; return 8 * (i >> 2) + 4 * n + (i & 3); }

struct Unit { int pm, pn; };
struct Gemm { const bf16_t* A; const bf16_t* Bt; int M, N, K; };

struct StaticOrder {
    int nM, nN, nwg, G, c;
    __host__ __device__ void init(int M, int N, int G_, int c_) { nM = M / BM; nN = N / BM; nwg = nM * nN; G = G_; c = c_; }
    __host__ __device__ bool next(int i, Unit& u) const {
        const long L = (long)i * G + c; if (L >= nwg) return false;
        int wgid = (int)L; { const int q = nwg / NXCD, r = nwg % NXCD, xcd = wgid % NXCD, off = wgid / NXCD; wgid = (xcd < r ? xcd * (q + 1) : r * (q + 1) + (xcd - r) * q) + off; }
        const int nig = WGM * nN, gid = wgid / nig, fm = gid * WGM, gsz = (nM - fm) < WGM ? (nM - fm) : WGM;
        u.pm = fm + ((wgid % nig) % gsz); u.pn = (wgid % nig) / gsz; return true;
    }
    __device__ __forceinline__ void a_ready(const Unit&) const {}
    __device__ __forceinline__ void done(const Unit&) const {}
};


typedef float f32x2_t __attribute__((ext_vector_type(2))); typedef __bf16 bf16x2_t __attribute__((ext_vector_type(2)));
__device__ __forceinline__ unsigned cvt_pk_bf16(float lo, float hi) { const f32x2_t v = {lo, hi}; const bf16x2_t b = __builtin_convertvector(v, bf16x2_t); return __builtin_bit_cast(unsigned, b); }
__device__ __forceinline__ float bf_lo(unsigned w) { return __uint_as_float(w << 16); }
__device__ __forceinline__ float bf_hi(unsigned w) { return __uint_as_float(w & 0xffff0000u); }
__device__ __forceinline__ float sigmoid_f(float x) { return __builtin_amdgcn_rcpf(1.0f + __builtin_amdgcn_exp2f(-1.4426950408889634f * x)); }
__device__ __forceinline__ float gelu_tanh_f(float x) { const float y = x * (1.0f + 0.044715f * x * x); return x * __builtin_amdgcn_rcpf(1.0f + __builtin_amdgcn_exp2f(-2.302208198144325f * y)); }
__device__ __forceinline__ u32x4 pack8(const f32x4 v0, const f32x4 v1) { u32x4 w; w.x = cvt_pk_bf16(v0[0], v0[1]); w.y = cvt_pk_bf16(v0[2], v0[3]); w.z = cvt_pk_bf16(v1[0], v1[1]); w.w = cvt_pk_bf16(v1[2], v1[3]); return w; }

constexpr int SEQ_ = 8192;
struct EpiProj {
    static constexpr bool PERM = true, AFTER_DRAIN = false, MIDK = false;
    bf16_t *QKV, *GUS, *SG; const float* rope; const float* rs;
    static __device__ __forceinline__ f32x4 deq(const f32x4 a, float sc) { const i32x4 q = __builtin_bit_cast(i32x4, a); return (f32x4){(float)q[0] * sc, (float)q[1] * sc, (float)q[2] * sc, (float)q[3] * sc}; }
    __device__ __forceinline__ void operator()(const f32x4 (&acc)[2][2][4][2], const Unit& u, int wr, int wc, int fr, int fq) const {
        const int row0 = u.pm * BM + wr * 64 + fr, pn = u.pn;
        if (pn < 24) {
            const int sect = pn >> 3;
            bf16_t* base = QKV + (size_t)sect * ((size_t)SEQ_ * 2048);
            const bool do_rope = (sect < 2) && (wc == 0);
            const float sg = (fq & 2) ? 1.f : -1.f;
#pragma unroll
            for (int bj = 0; bj < 2; ++bj) {
                bf16_t* dst = base + (size_t)((pn & 7) * 2 + bj) * ((size_t)SEQ_ * 128) + wc * 32 + 8 * fq;
#pragma unroll
                for (int ai = 0; ai < 2; ++ai)
#pragma unroll
                    for (int m = 0; m < 4; ++m) { const int row = row0 + ai * HALF + m * 16; const float sc = rs[row];
                        f32x4 v0 = deq(acc[ai][bj][m][0], sc), v1 = deq(acc[ai][bj][m][1], sc);
                        if (do_rope) {
                            f32x4 p0, p1;
#pragma unroll
                            for (int e = 0; e < 4; ++e) { p0[e] = __shfl_xor(v0[e], 32); p1[e] = __shfl_xor(v1[e], 32); }
                            const f32x4* t = (const f32x4*)(rope + ((size_t)row * 16 + 8 * (fq & 1)) * 2);
                            const f32x4 t0 = t[0], t1 = t[1], t2 = t[2], t3 = t[3];
                            v0[0] = v0[0] * t0[0] + sg * p0[0] * t0[1]; v0[1] = v0[1] * t0[2] + sg * p0[1] * t0[3];
                            v0[2] = v0[2] * t1[0] + sg * p0[2] * t1[1]; v0[3] = v0[3] * t1[2] + sg * p0[3] * t1[3];
                            v1[0] = v1[0] * t2[0] + sg * p1[0] * t2[1]; v1[1] = v1[1] * t2[2] + sg * p1[1] * t2[3];
                            v1[2] = v1[2] * t3[0] + sg * p1[2] * t3[1]; v1[3] = v1[3] * t3[2] + sg * p1[3] * t3[3];
                        }
                        *(u32x4*)(dst + (size_t)row * 128) = pack8(v0, v1); }
            }
        } else {
            const bool gel = pn < 40;
            const int rel = gel ? pn - 24 : pn - 40, ldc = gel ? 2048 : 4096, per = gel ? 8 : 16, which = rel >= per ? 1 : 0, colt = (rel - which * per) * BM;
            bf16_t* base = (gel ? GUS : SG) + (size_t)which * ((size_t)SEQ_ * ldc);
            const int col0 = colt + wc * 32 + 8 * fq;
#pragma unroll
            for (int ai = 0; ai < 2; ++ai)
#pragma unroll
                for (int m = 0; m < 4; ++m) { const int row = row0 + ai * HALF + m * 16; const float sc = rs[row]; bf16_t* rowp = base + (size_t)row * ldc + col0;
#pragma unroll
                    for (int bj = 0; bj < 2; ++bj) { f32x4 v0 = deq(acc[ai][bj][m][0], sc), v1 = deq(acc[ai][bj][m][1], sc);
                        if (gel) {
#pragma unroll
                            for (int e = 0; e < 4; ++e) { v0[e] = gelu_tanh_f(v0[e]); v1[e] = gelu_tanh_f(v1[e]); } }
                        else {
#pragma unroll
                            for (int e = 0; e < 4; ++e) { v0[e] = sigmoid_f(v0[e]); v1[e] = sigmoid_f(v1[e]); } }
                        *(u32x4*)(rowp + bj * HALF) = pack8(v0, v1); } }
        }
    }
};
struct EpiGates {
    static constexpr bool PERM = true, AFTER_DRAIN = false, MIDK = false;
    bf16_t* SG;
    __device__ __forceinline__ void operator()(const f32x4 (&acc)[2][2][4][2], const Unit& u, int wr, int wc, int fr, int fq) const {
        const int row0 = u.pm * BM + wr * 64 + fr, which = u.pn >> 4, col0 = (u.pn & 15) * BM + wc * 32 + 8 * fq;
        bf16_t* base = SG + (size_t)which * ((size_t)SEQ_ * 4096);
#pragma unroll
        for (int ai = 0; ai < 2; ++ai)
#pragma unroll
            for (int m = 0; m < 4; ++m) { bf16_t* rowp = base + (size_t)(row0 + ai * HALF + m * 16) * 4096 + col0;
#pragma unroll
                for (int bj = 0; bj < 2; ++bj) { f32x4 v0 = acc[ai][bj][m][0], v1 = acc[ai][bj][m][1];
#pragma unroll
                    for (int e = 0; e < 4; ++e) { v0[e] = sigmoid_f(v0[e]); v1[e] = sigmoid_f(v1[e]); }
                    *(u32x4*)(rowp + bj * HALF) = pack8(v0, v1); } }
    }
};
template <bool FIRST> struct EpiGate {
    static constexpr bool PERM = true, AFTER_DRAIN = false, MIDK = false;
    const bf16_t* gate; bf16_t* MG;
    __device__ __forceinline__ void operator()(const f32x4 (&acc)[2][2][4][2], const Unit& u, int wr, int wc, int fr, int fq) const {
        const int row0 = u.pm * BM + wr * 64 + fr, col0 = u.pn * BM + wc * 32 + 8 * fq;
#pragma unroll
        for (int ai = 0; ai < 2; ++ai)
#pragma unroll
            for (int m = 0; m < 4; ++m) { const size_t off = (size_t)(row0 + ai * HALF + m * 16) * 4096 + col0;
#pragma unroll
                for (int bj = 0; bj < 2; ++bj) { const u32x4 gw = *(const u32x4*)(gate + off + bj * HALF);
                    f32x4 v0 = acc[ai][bj][m][0], v1 = acc[ai][bj][m][1];
                    v0[0] *= bf_lo(gw.x); v0[1] *= bf_hi(gw.x); v0[2] *= bf_lo(gw.y); v0[3] *= bf_hi(gw.y);
                    v1[0] *= bf_lo(gw.z); v1[1] *= bf_hi(gw.z); v1[2] *= bf_lo(gw.w); v1[3] *= bf_hi(gw.w);
                    if (!FIRST) { const u32x4 mw = *(const u32x4*)(MG + off + bj * HALF);
                        v0[0] += bf_lo(mw.x); v0[1] += bf_hi(mw.x); v0[2] += bf_lo(mw.y); v0[3] += bf_hi(mw.y);
                        v1[0] += bf_lo(mw.z); v1[1] += bf_hi(mw.z); v1[2] += bf_lo(mw.w); v1[3] += bf_hi(mw.w); }
                    *(u32x4*)(MG + off + bj * HALF) = pack8(v0, v1); } }
    }
};
struct EpiGate2 {
    static constexpr bool PERM = true, AFTER_DRAIN = false, MIDK = true;
    const bf16_t* ga; const bf16_t* gb; bf16_t* MG;
    __device__ __forceinline__ void mid(f32x4 (&acc)[2][2][4][2], const Unit& u, int wr, int wc, int fr, int fq) const {
        int row0 = u.pm * BM + wr * 64 + fr; const int col0 = u.pn * BM + wc * 32 + 8 * fq;
        asm volatile("" : "+v"(row0));
#pragma unroll
        for (int ai = 0; ai < 2; ++ai)
#pragma unroll
            for (int m = 0; m < 4; ++m) { const size_t off = (size_t)(row0 + ai * HALF + m * 16) * 4096 + col0;
#pragma unroll
                for (int bj = 0; bj < 2; ++bj) { const u32x4 a = *(const u32x4*)(ga + off + bj * HALF), b = *(const u32x4*)(gb + off + bj * HALF);
                    f32x4 r0 = {bf_lo(b.x), bf_hi(b.x), bf_lo(b.y), bf_hi(b.y)}, r1 = {bf_lo(b.z), bf_hi(b.z), bf_lo(b.w), bf_hi(b.w)};
#pragma unroll
                    for (int e = 0; e < 4; ++e) { r0[e] = __builtin_amdgcn_rcpf(fmaxf(r0[e], 1e-30f)); r1[e] = __builtin_amdgcn_rcpf(fmaxf(r1[e], 1e-30f)); }
                    const f32x4 a0 = {bf_lo(a.x), bf_hi(a.x), bf_lo(a.y), bf_hi(a.y)}, a1 = {bf_lo(a.z), bf_hi(a.z), bf_lo(a.w), bf_hi(a.w)};
                    acc[ai][bj][m][0] *= a0 * r0; acc[ai][bj][m][1] *= a1 * r1;
                    asm volatile("" : "+v"(acc[ai][bj][m][0]), "+v"(acc[ai][bj][m][1])); asm volatile("" ::: "memory"); } }
    }
    __device__ __forceinline__ void operator()(const f32x4 (&acc)[2][2][4][2], const Unit& u, int wr, int wc, int fr, int fq) const {
        int row0 = u.pm * BM + wr * 64 + fr; const int col0 = u.pn * BM + wc * 32 + 8 * fq;
        asm volatile("" : "+v"(row0));
#pragma unroll
        for (int ai = 0; ai < 2; ++ai)
#pragma unroll
            for (int m = 0; m < 4; ++m) { const size_t off = (size_t)(row0 + ai * HALF + m * 16) * 4096 + col0;
#pragma unroll
                for (int bj = 0; bj < 2; ++bj) { const u32x4 b = *(const u32x4*)(gb + off + bj * HALF);
                    f32x4 v0 = acc[ai][bj][m][0], v1 = acc[ai][bj][m][1];
                    v0[0] *= bf_lo(b.x); v0[1] *= bf_hi(b.x); v0[2] *= bf_lo(b.y); v0[3] *= bf_hi(b.y);
                    v1[0] *= bf_lo(b.z); v1[1] *= bf_hi(b.z); v1[2] *= bf_lo(b.w); v1[3] *= bf_hi(b.w);
                    *(u32x4*)(MG + off + bj * HALF) = pack8(v0, v1); } }
    }
};
struct EpiRes {
    static constexpr bool PERM = false, AFTER_DRAIN = false, MIDK = false;
    const float* res; float* out; const float* bias; float alpha;
    __device__ __forceinline__ void operator()(const f32x4 (&acc)[2][2][4][2], const Unit& u, int wr, int wc, int fr, int fq) const {
        const int row0 = u.pm * BM + wr * 64 + fr, col0 = u.pn * BM + wc * 32 + 4 * fq;
        f32x4 bv[2][2];
#pragma unroll
        for (int bj = 0; bj < 2; ++bj)
#pragma unroll
            for (int n = 0; n < 2; ++n) bv[bj][n] = bias ? *(const f32x4*)(bias + col0 + bj * HALF + n * 16) : (f32x4){0.f, 0.f, 0.f, 0.f};
#pragma unroll
        for (int ai = 0; ai < 2; ++ai)
#pragma unroll
            for (int m = 0; m < 4; ++m) { const size_t off = (size_t)(row0 + ai * HALF + m * 16) * 4096 + col0;
#pragma unroll
                for (int bj = 0; bj < 2; ++bj)
#pragma unroll
                    for (int n = 0; n < 2; ++n) { const f32x4 r = *(const f32x4*)(res + off + bj * HALF + n * 16);
                        *(f32x4*)(out + off + bj * HALF + n * 16) = r * alpha + (acc[ai][bj][m][n] + bv[bj][n]); } }
    }
};
template <bool RES_BF16> struct EpiResB {
    static constexpr bool PERM = true, AFTER_DRAIN = false, MIDK = false;
    const void* res; bf16_t* out; const float* bias; float alpha;
    __device__ __forceinline__ void operator()(const f32x4 (&acc)[2][2][4][2], const Unit& u, int wr, int wc, int fr, int fq) const {
        const int row0 = u.pm * BM + wr * 64 + fr, col0 = u.pn * BM + wc * 32 + 8 * fq;
        f32x4 bv[2][2];
#pragma unroll
        for (int bj = 0; bj < 2; ++bj)
#pragma unroll
            for (int n = 0; n < 2; ++n) bv[bj][n] = bias ? *(const f32x4*)(bias + col0 + bj * HALF + 4 * n) : (f32x4){0.f, 0.f, 0.f, 0.f};
#pragma unroll
        for (int ai = 0; ai < 2; ++ai)
#pragma unroll
            for (int m = 0; m < 4; ++m) { const size_t off = (size_t)(row0 + ai * HALF + m * 16) * 4096 + col0;
#pragma unroll
                for (int bj = 0; bj < 2; ++bj) { f32x4 r0, r1;
                    if (RES_BF16) { const u32x4 w = *(const u32x4*)((const bf16_t*)res + off + bj * HALF);
                        r0 = (f32x4){bf_lo(w.x), bf_hi(w.x), bf_lo(w.y), bf_hi(w.y)}; r1 = (f32x4){bf_lo(w.z), bf_hi(w.z), bf_lo(w.w), bf_hi(w.w)}; }
                    else { r0 = *(const f32x4*)((const float*)res + off + bj * HALF); r1 = *(const f32x4*)((const float*)res + off + bj * HALF + 4); }
                    const f32x4 v0 = r0 * alpha + (acc[ai][bj][m][0] + bv[bj][0]), v1 = r1 * alpha + (acc[ai][bj][m][1] + bv[bj][1]);
                    *(u32x4*)(out + off + bj * HALF) = pack8(v0, v1); } }
    }
};
template <bool DQ = false> struct EpiRelu2 {
    static constexpr bool PERM = true, AFTER_DRAIN = false, MIDK = false;
    bf16_t* Z; int ldc; const float* bias; const float* rs = nullptr;
    __device__ __forceinline__ void operator()(const f32x4 (&acc)[2][2][4][2], const Unit& u, int wr, int wc, int fr, int fq) const {
        const int row0 = u.pm * BM + wr * 64 + fr, col0 = u.pn * BM + wc * 32 + 8 * fq;
        f32x4 bv[2][2];
#pragma unroll
        for (int bj = 0; bj < 2; ++bj)
#pragma unroll
            for (int n = 0; n < 2; ++n) bv[bj][n] = *(const f32x4*)(bias + col0 + bj * HALF + 4 * n);
#pragma unroll
        for (int ai = 0; ai < 2; ++ai)
#pragma unroll
            for (int m = 0; m < 4; ++m) { bf16_t* rowp = Z + (size_t)(row0 + ai * HALF + m * 16) * ldc + col0; const float sc = DQ ? rs[row0 + ai * HALF + m * 16] : 1.f;
#pragma unroll
                for (int bj = 0; bj < 2; ++bj) { f32x4 v0 = (DQ ? EpiProj::deq(acc[ai][bj][m][0], sc) : acc[ai][bj][m][0]) + bv[bj][0], v1 = (DQ ? EpiProj::deq(acc[ai][bj][m][1], sc) : acc[ai][bj][m][1]) + bv[bj][1];
#pragma unroll
                    for (int e = 0; e < 4; ++e) { const float a = fmaxf(v0[e], 0.f), b = fmaxf(v1[e], 0.f); v0[e] = a * a; v1[e] = b * b; }
                    *(u32x4*)(rowp + bj * HALF) = pack8(v0, v1); } }
    }
};

template <class Epi, class Sched, bool ALIGN_EPI = false, bool SP2 = false, bool FP8 = false, bool I8 = false>
__device__ __forceinline__ void gemm_phase(PG8_LAS unsigned char* lds, const Gemm g, const Sched& S, const Epi& E) {
    const int tid = threadIdx.x, wid = __builtin_amdgcn_readfirstlane(tid >> 6), lane = tid & 63, wr = wid >> 2, wc = wid & 3, fr = lane & 15, fq = lane >> 4;
    const int K = (FP8 || I8) ? g.K / 2 : g.K, nt = K / BK;
    unsigned voffA[2], voffB[2];
#pragma unroll
    for (int i = 0; i < 2; ++i) { int R, C; stage_rc(tid * 16 + i * 8192, R, C); const int Rb = Epi::PERM ? ((R & ~31) + perm32(R & 31)) : R;
        voffA[i] = (unsigned)(R * K + C) * 2u; voffB[i] = (unsigned)(Rb * K + C) * 2u; }
    const size_t kstep = (size_t)(BK * 2);
    const size_t hstep = (size_t)HALF * K * 2;
    const size_t tstep = 2 * hstep;
    const unsigned ldsw = (unsigned)wid * 1024u;
    const int aoff = lds_byte(wr * 64 + fr, fq * 8), boff = lds_byte(wc * 32 + fr, fq * 8);
#define PG8_SA(b, h) (((b) * 2 + (h)) * HTB)
#define PG8_SB(b, h) ((4 + (b) * 2 + (h)) * HTB)
#define PG8_STAGE(bufoff, gbase, voff) do { _Pragma("unroll") for (int _i = 0; _i < 2; ++_i) \
        __builtin_amdgcn_global_load_lds((const unsigned*)((const char*)(gbase) + (voff)[_i]), (PG8_LAS unsigned*)(lds + (bufoff) + ldsw + _i * 8192), 16, 0, 0); } while (0)
#define PG8_LDA(dst, b, h) do { if constexpr (FP8) { _Pragma("unroll") for (int m = 0; m < 4; ++m) { const i32x4 lo_ = *(const PG8_LAS i32x4*)(lds + PG8_SA(b, h) + aoff + m * 2048), hi_ = *(const PG8_LAS i32x4*)(lds + PG8_SA(b, h) + aoff + m * 2048 + 1024); \
            dst##8[m] = __builtin_shufflevector(lo_, hi_, 0, 1, 2, 3, 4, 5, 6, 7); } } \
        else { _Pragma("unroll") for (int m = 0; m < 4; ++m) _Pragma("unroll") for (int k = 0; k < 2; ++k) dst[m][k] = *(const PG8_LAS bf16x8*)(lds + PG8_SA(b, h) + aoff + m * 2048 + k * 1024); } } while (0)
#define PG8_LDB(dst, b, h) do { if constexpr (FP8) { _Pragma("unroll") for (int n = 0; n < 2; ++n) { const i32x4 lo_ = *(const PG8_LAS i32x4*)(lds + PG8_SB(b, h) + boff + n * 2048), hi_ = *(const PG8_LAS i32x4*)(lds + PG8_SB(b, h) + boff + n * 2048 + 1024); \
            dst##8[n] = __builtin_shufflevector(lo_, hi_, 0, 1, 2, 3, 4, 5, 6, 7); } } \
        else { _Pragma("unroll") for (int n = 0; n < 2; ++n) _Pragma("unroll") for (int k = 0; k < 2; ++k) dst[n][k] = *(const PG8_LAS bf16x8*)(lds + PG8_SB(b, h) + boff + n * 2048 + k * 1024); } } while (0)
#define PG8_MMA(ai, bj, At, Bt) do { __builtin_amdgcn_s_setprio(1); \
        if constexpr (FP8) { _Pragma("unroll") for (int m = 0; m < 4; ++m) _Pragma("unroll") for (int n = 0; n < 2; ++n) \
            asm volatile("v_mfma_scale_f32_16x16x128_f8f6f4 %0, %1, %2, %0, %3, %4 op_sel_hi:[0,0,0]" : "+v"(acc[ai][bj][m][n]) : "v"(Bt##8[n]), "v"(At##8[m]), "v"(sc_w8), "v"(sc_a8)); } \
        else if constexpr (I8) { _Pragma("unroll") for (int m = 0; m < 4; ++m) _Pragma("unroll") for (int n = 0; n < 2; ++n) _Pragma("unroll") for (int k = 0; k < 2; ++k) \
            acc[ai][bj][m][n] = __builtin_bit_cast(f32x4, __builtin_amdgcn_mfma_i32_16x16x64_i8(__builtin_bit_cast(i32x4, Bt[n][k]), __builtin_bit_cast(i32x4, At[m][k]), __builtin_bit_cast(i32x4, acc[ai][bj][m][n]), 0, 0, 0)); } \
        else { _Pragma("unroll") for (int m = 0; m < 4; ++m) _Pragma("unroll") for (int n = 0; n < 2; ++n) _Pragma("unroll") for (int k = 0; k < 2; ++k) \
            acc[ai][bj][m][n] = __builtin_amdgcn_mfma_f32_16x16x32_bf16(Bt[n][k], At[m][k], acc[ai][bj][m][n], 0, 0, 0); } \
        __builtin_amdgcn_s_setprio(0); } while (0)
#define PG8_WAIT_V(n) asm volatile("s_waitcnt vmcnt(" #n ")" ::: "memory")
#define PG8_WAIT_L(n) asm volatile("s_waitcnt lgkmcnt(" #n ")" ::: "memory")
#define PG8_BAR __builtin_amdgcn_s_barrier()
#define PG8_SCHED __builtin_amdgcn_sched_barrier(0)
    Unit cur, nxt; int ui = 0;
    if (!S.next(0, cur)) return;
    f32x4 acc[2][2][4][2];
#pragma unroll
    for (int a = 0; a < 2; ++a)
#pragma unroll
        for (int b = 0; b < 2; ++b)
#pragma unroll
            for (int m = 0; m < 4; ++m)
#pragma unroll
                for (int n = 0; n < 2; ++n) acc[a][b][m][n] = (f32x4){0.f, 0.f, 0.f, 0.f};
    const int sc_w8 = 0x79797979, sc_a8 = 0x7F7F7F7F;
    bf16x8 At[4][2], B0[2][2], B1[2][2]; i32x8 At8[4], B08[2], B18[2];
    const char* cA = (const char*)g.A + (size_t)cur.pm * tstep; const char* cB = (const char*)g.Bt + (size_t)cur.pn * tstep;
    S.a_ready(cur);
    if constexpr (SP2) {
        PG8_STAGE(PG8_SB(0, 0), cB, voffB); PG8_STAGE(PG8_SB(0, 1), cB + hstep, voffB); PG8_STAGE(PG8_SA(0, 0), cA, voffA); PG8_STAGE(PG8_SA(0, 1), cA + hstep, voffA);
        if (wr == 1) PG8_BAR;
        PG8_WAIT_V(2); PG8_BAR;
        PG8_STAGE(PG8_SB(1, 0), cB + kstep, voffB); PG8_STAGE(PG8_SA(1, 0), cA + kstep, voffA); PG8_STAGE(PG8_SB(1, 1), cB + hstep + kstep, voffB);
        PG8_WAIT_V(6); PG8_BAR;
    } else {
        PG8_STAGE(PG8_SB(0, 0), cB, voffB); PG8_STAGE(PG8_SA(0, 0), cA, voffA); PG8_STAGE(PG8_SB(0, 1), cB + hstep, voffB); PG8_STAGE(PG8_SA(0, 1), cA + hstep, voffA);
        if (wr == 1) PG8_BAR;
        PG8_WAIT_V(4); PG8_BAR;
        PG8_STAGE(PG8_SB(1, 0), cB + kstep, voffB); PG8_STAGE(PG8_SA(1, 0), cA + kstep, voffA); PG8_STAGE(PG8_SB(1, 1), cB + hstep + kstep, voffB);
        PG8_WAIT_V(6); PG8_BAR;
    }
    for (;;) {
        const bool has_next = S.next(ui + 1, nxt);
        const char* nA = has_next ? (const char*)g.A + (size_t)nxt.pm * tstep : cA; const char* nB = has_next ? (const char*)g.Bt + (size_t)nxt.pn * tstep : cB;
        constexpr int nseg = Epi::MIDK ? 2 : 1; const int tseg = nt / nseg;
        for (int sg = 0; sg < nseg; ++sg) {
        for (int t = sg * tseg; t < (sg + 1) * tseg; t += 2) {
            const bool last = (t == nt - 2);
            const char* a1 = cA + (size_t)(t + 1) * kstep;
            const char* a2 = last ? nA : cA + (size_t)(t + 2) * kstep; const char* b2 = last ? nB : cB + (size_t)(t + 2) * kstep;
            const char* a3 = a2 + kstep; const char* b3 = b2 + kstep;
            if (last && has_next) S.a_ready(nxt);
            if constexpr (SP2) {
            PG8_LDB(B0, 0, 0); PG8_LDB(B1, 0, 1); PG8_SCHED; PG8_LDA(At, 0, 0); PG8_STAGE(PG8_SA(1, 1), a1 + hstep, voffA);
            PG8_WAIT_V(8); PG8_WAIT_L(0); PG8_BAR; PG8_MMA(0, 0, At, B0); PG8_MMA(0, 1, At, B1); PG8_BAR; PG8_SCHED;
            PG8_LDA(At, 0, 1); PG8_STAGE(PG8_SB(0, 0), b2, voffB); PG8_STAGE(PG8_SB(0, 1), b2 + hstep, voffB); PG8_STAGE(PG8_SA(0, 0), a2, voffA);
            PG8_WAIT_V(8); PG8_WAIT_L(0); PG8_BAR; PG8_MMA(1, 0, At, B0); PG8_MMA(1, 1, At, B1); PG8_BAR; PG8_SCHED;
            PG8_LDB(B0, 1, 0); PG8_LDB(B1, 1, 1); PG8_SCHED; PG8_LDA(At, 1, 0); PG8_STAGE(PG8_SA(0, 1), a2 + hstep, voffA);
            PG8_WAIT_V(8); PG8_WAIT_L(0); PG8_BAR; PG8_MMA(0, 0, At, B0); PG8_MMA(0, 1, At, B1); PG8_BAR; PG8_SCHED;
            PG8_LDA(At, 1, 1); PG8_STAGE(PG8_SB(1, 0), b3, voffB); PG8_STAGE(PG8_SB(1, 1), b3 + hstep, voffB); PG8_STAGE(PG8_SA(1, 0), a3, voffA);
            PG8_WAIT_V(8); PG8_WAIT_L(0); PG8_BAR; PG8_MMA(1, 0, At, B0); PG8_MMA(1, 1, At, B1); PG8_BAR; PG8_SCHED;
            } else {
            PG8_LDB(B0, 0, 0); PG8_SCHED; PG8_LDA(At, 0, 0); PG8_STAGE(PG8_SA(1, 1), a1 + hstep, voffA);
            PG8_WAIT_L(8); PG8_BAR; PG8_WAIT_L(0); PG8_MMA(0, 0, At, B0); PG8_BAR; PG8_SCHED;
            PG8_LDB(B1, 0, 1); PG8_STAGE(PG8_SB(0, 0), b2, voffB);
            PG8_BAR; PG8_WAIT_L(0); PG8_MMA(0, 1, At, B1); PG8_BAR;
            PG8_LDA(At, 0, 1); PG8_STAGE(PG8_SA(0, 0), a2, voffA);
            PG8_BAR; PG8_WAIT_L(0); PG8_MMA(1, 0, At, B0); PG8_BAR; PG8_SCHED;
            PG8_STAGE(PG8_SB(0, 1), b2 + hstep, voffB);
            PG8_WAIT_V(6); PG8_BAR; PG8_MMA(1, 1, At, B1); PG8_BAR;
            PG8_LDB(B0, 1, 0); PG8_SCHED; PG8_LDA(At, 1, 0); PG8_STAGE(PG8_SA(0, 1), a2 + hstep, voffA);
            PG8_WAIT_L(8); PG8_BAR; PG8_WAIT_L(0); PG8_MMA(0, 0, At, B0); PG8_BAR; PG8_SCHED;
            PG8_LDB(B1, 1, 1); PG8_STAGE(PG8_SB(1, 0), b3, voffB);
            PG8_BAR; PG8_WAIT_L(0); PG8_MMA(0, 1, At, B1); PG8_BAR;
            PG8_LDA(At, 1, 1); PG8_STAGE(PG8_SA(1, 0), a3, voffA);
            PG8_BAR; PG8_WAIT_L(0); PG8_MMA(1, 0, At, B0); PG8_BAR; PG8_SCHED;
            PG8_STAGE(PG8_SB(1, 1), b3 + hstep, voffB);
            PG8_WAIT_V(6); PG8_BAR; PG8_MMA(1, 1, At, B1); PG8_BAR;
            }
        }
        if constexpr (Epi::MIDK) { if (sg == 0) E.mid(acc, cur, wr, wc, fr, fq); }
        }
        if constexpr (ALIGN_EPI) { if (wr == 0) PG8_BAR; }
        if constexpr (FP8) asm volatile("s_nop 15\n\ts_nop 15" ::: "memory");
        if constexpr (!Epi::AFTER_DRAIN) { E(acc, cur, wr, wc, fr, fq); S.done(cur); }
        if (!has_next) break;
#pragma unroll
        for (int a = 0; a < 2; ++a)
#pragma unroll
            for (int b = 0; b < 2; ++b)
#pragma unroll
                for (int m = 0; m < 4; ++m)
#pragma unroll
                    for (int n = 0; n < 2; ++n) acc[a][b][m][n] = (f32x4){0.f, 0.f, 0.f, 0.f};
        cur = nxt; cA = nA; cB = nB; ++ui;
        if constexpr (ALIGN_EPI) { if (wr == 1) PG8_BAR; }
    }
    PG8_WAIT_V(0);
    if constexpr (!ALIGN_EPI) { if (wr == 0) PG8_BAR; }
    PG8_BAR;
    if constexpr (Epi::AFTER_DRAIN) { E.fused(acc, cur, wr, wc, fr, fq, lds, wid, lane); S.done(cur); }
#undef PG8_SA
#undef PG8_SB
#undef PG8_STAGE
#undef PG8_LDA
#undef PG8_LDB
#undef PG8_MMA
#undef PG8_WAIT_V
#undef PG8_WAIT_L
#undef PG8_BAR
#undef PG8_SCHED
}
}

namespace att {
enum { ORDER_NATURAL = 0, ORDER_REVERSED = 1, ORDER_PAIRED = 2, ORDER_XCD = 4 };
constexpr int B = 1, H = 32, HKV = 32, SQ = 8192, SKV = 8192, D = 128, QOFF = 0, WINDOW = SKV;
constexpr float THR = 8.f;
constexpr bool WSKIP = false;
constexpr float SCALE = 0.08838834764831845f;
constexpr int NW = 8, QBLK = 32, KVBLK = 64, QB = NW * QBLK;
constexpr int SHM_V = KVBLK * D * 2, SHM_K = KVBLK * D * 2;
constexpr int LDS_BYTES = 2 * SHM_V + 2 * SHM_K + NW * 64 * 4;
static_assert(D == 128 && SQ % QB == 0 && SKV % KVBLK == 0 && H % HKV == 0 && QOFF >= 0 && QOFF + SQ <= SKV && WINDOW >= 1, "geometry");

using bf16 = __hip_bfloat16;
typedef short bf16x8 __attribute__((ext_vector_type(8)));
typedef short s16x4 __attribute__((ext_vector_type(4)));
typedef float f32x16 __attribute__((ext_vector_type(16)));
typedef float f32x4 __attribute__((ext_vector_type(4)));
typedef unsigned u32x4 __attribute__((ext_vector_type(4)));
template <class A, class Bt> struct same_t { static constexpr bool v = false; };
template <class A> struct same_t<A, A> { static constexpr bool v = true; };

#define KSWZ(row, colB) ((row) * 256 + ((colB) ^ (((row) & 7) << 4)))
#define SBAR() __builtin_amdgcn_sched_barrier(0)
__device__ __forceinline__ int v_st(int k, int c) { const int kk = (k & ~0xC) | ((k & 4) << 1) | ((k & 8) >> 1); return ((kk >> 3) * 4 + (c >> 5)) * 512 + ((kk & 7) * 32 + (c & 31)) * 2; }
__device__ __forceinline__ int v_rd_base(int lane) { return ((lane & 3) << 3) | (((lane >> 2) & 3) << 6) | (((lane >> 4) & 1) << 5) | (((lane >> 5) & 1) << 8); }
constexpr int v_rd_off(int d0, int ks, int half) { return d0 * 512 + ks * 4096 + half * 2048; }
__device__ __forceinline__ int crow(int r, int hi) { return (r & 3) + 8 * (r >> 2) + 4 * hi; }
__device__ __forceinline__ unsigned cvtpk(float lo, float hi) {
    typedef float f32x2_t __attribute__((ext_vector_type(2))); typedef __bf16 bf16x2_t __attribute__((ext_vector_type(2)));
    const f32x2_t v = {lo, hi}; const bf16x2_t b = __builtin_convertvector(v, bf16x2_t); return __builtin_bit_cast(unsigned, b);
}
__device__ __forceinline__ bf16x8 pack8(f32x4 a, f32x4 b) {
    u32x4 w = {cvtpk(a[0], a[1]), cvtpk(a[2], a[3]), cvtpk(b[0], b[1]), cvtpk(b[2], b[3])};
    return *reinterpret_cast<bf16x8*>(&w);
}
template <class T> __device__ __forceinline__ bf16x8 load8(const T* p) {
    if constexpr (same_t<T, float>::v) { return pack8(*(const f32x4*)p, *(const f32x4*)(p + 4)); }
    else { return *reinterpret_cast<const bf16x8*>(p); }
}
__device__ __forceinline__ void mask_tile(f32x16& p0, f32x16& p1, int dq, unsigned W) {
    const float NEG = -__builtin_inff();
#pragma unroll
    for (int r = 0; r < 16; ++r) {
        const int c = (r & 3) + 8 * (r >> 2);
        if ((unsigned)(dq - c) >= W) p0[r] = NEG;
        if ((unsigned)(dq - c - 32) >= W) p1[r] = NEG;
    }
}
__device__ __forceinline__ void partialSM(f32x16& p0, f32x16& p1, float& m_reg, float& mn, float& alpha) {
    float pmax = p0[0]; for (int r = 1; r < 16; ++r) pmax = fmaxf(pmax, p0[r]); for (int r = 0; r < 16; ++r) pmax = fmaxf(pmax, p1[r]);
    { auto rr = __builtin_amdgcn_permlane32_swap(__float_as_uint(pmax), __float_as_uint(pmax), false, false);
      pmax = fmaxf(__uint_as_float(rr[0]), __uint_as_float(rr[1])); }
    constexpr float C2 = 1.4426950408889634f * SCALE;
    if (__builtin_expect(__all((pmax - m_reg) * SCALE <= THR), 1)) { mn = m_reg; alpha = 1.f; }
    else { mn = fmaxf(m_reg, pmax); alpha = __builtin_amdgcn_exp2f((m_reg - mn) * C2); m_reg = mn; }
    const float mnL = -mn * C2;
    for (int r = 0; r < 16; ++r) p0[r] = fmaf(p0[r], C2, mnL); for (int r = 0; r < 16; ++r) p1[r] = fmaf(p1[r], C2, mnL);
    for (int r = 0; r < 16; ++r) p0[r] = __builtin_amdgcn_exp2f(p0[r]);
}
__device__ __forceinline__ void finishSM(f32x16& p0, f32x16& p1, float alpha, float& l_reg, bf16x8& pa0, bf16x8& pa1, bf16x8& pa2, bf16x8& pa3) {
    for (int r = 0; r < 16; ++r) p1[r] = __builtin_amdgcn_exp2f(p1[r]);
    float ps = 0; for (int r = 0; r < 16; ++r) ps += p0[r]; for (int r = 0; r < 16; ++r) ps += p1[r];
    { auto rr = __builtin_amdgcn_permlane32_swap(__float_as_uint(ps), __float_as_uint(ps), false, false);
      ps = __uint_as_float(rr[0]) + __uint_as_float(rr[1]); }
    l_reg = l_reg * alpha + ps;
#define PK4(P, B_, OUT) do { unsigned a0 = cvtpk(P[B_+0], P[B_+1]), a1 = cvtpk(P[B_+2], P[B_+3]);                          \
        unsigned b0 = cvtpk(P[B_+4], P[B_+5]), b1 = cvtpk(P[B_+6], P[B_+7]);                                             \
        auto r0 = __builtin_amdgcn_permlane32_swap(a0, b0, false, false); auto r1 = __builtin_amdgcn_permlane32_swap(a1, b1, false, false); \
        u32x4 w = {r0[0], r1[0], r0[1], r1[1]}; OUT = *reinterpret_cast<bf16x8*>(&w); } while (0)
    PK4(p0, 0, pa0); PK4(p0, 8, pa1); PK4(p1, 0, pa2); PK4(p1, 8, pa3);
#undef PK4
}
template <int KB, bool SK>
__device__ __forceinline__ void qkt(f32x16& p0, f32x16& p1, const char* K_lds, int r32, int hi, const bf16x8* qr, bool act) {
    if (SK && !act) { const float NEG = -__builtin_inff();
#pragma unroll
        for (int r = 0; r < 16; ++r) { p0[r] = NEG; p1[r] = NEG; } return; }
    p0 = f32x16{}; p1 = f32x16{};
    const char* kb[4];
#pragma unroll
    for (int dd = 0; dd < 4; ++dd) kb[dd] = K_lds + KB * SHM_K + KSWZ(r32, (dd * 16 + hi * 8) * 2);
#pragma unroll
    for (int d0 = 0; d0 < 8; ++d0) { const char* a = kb[d0 & 3] + (d0 >> 2) * 128;
        bf16x8 b0 = *reinterpret_cast<const bf16x8*>(a);
        bf16x8 b1 = *reinterpret_cast<const bf16x8*>(a + 32 * 256);
        p0 = __builtin_amdgcn_mfma_f32_32x32x16_bf16(b0, qr[d0], p0, 0, 0, 0);
        p1 = __builtin_amdgcn_mfma_f32_32x32x16_bf16(b1, qr[d0], p1, 0, 0, 0); }
}
template <int VB, bool SK>
__device__ __forceinline__ void pv_tile(f32x16* o, int vb0, bf16x8 pa0, bf16x8 pa1, bf16x8 pa2, bf16x8 pa3, bool act) {
    if (SK && !act) return;
#define TRRD(dst, off) asm volatile("ds_read_b64_tr_b16 %0, %1 offset:%2" : "=&v"(dst) : "v"(vb0), "i"(off) : "memory")
#define PV_D0(d0) do { s16x4 l0, l1, l2, l3, h0, h1, h2, h3; constexpr int b_ = VB * SHM_V + v_rd_off(d0, 0, 0);     \
        TRRD(l0, b_); TRRD(h0, b_ + 2048); TRRD(l1, b_ + 4096); TRRD(h1, b_ + 6144); TRRD(l2, b_ + 8192); TRRD(h2, b_ + 10240); TRRD(l3, b_ + 12288); TRRD(h3, b_ + 14336); \
        asm volatile("s_waitcnt lgkmcnt(0)" ::: "memory"); SBAR();                 \
        o[d0] = __builtin_amdgcn_mfma_f32_32x32x16_bf16(pa0, (bf16x8){l0[0], l0[1], l0[2], l0[3], h0[0], h0[1], h0[2], h0[3]}, o[d0], 0, 0, 0);   \
        o[d0] = __builtin_amdgcn_mfma_f32_32x32x16_bf16(pa1, (bf16x8){l1[0], l1[1], l1[2], l1[3], h1[0], h1[1], h1[2], h1[3]}, o[d0], 0, 0, 0);   \
        o[d0] = __builtin_amdgcn_mfma_f32_32x32x16_bf16(pa2, (bf16x8){l2[0], l2[1], l2[2], l2[3], h2[0], h2[1], h2[2], h2[3]}, o[d0], 0, 0, 0);   \
        o[d0] = __builtin_amdgcn_mfma_f32_32x32x16_bf16(pa3, (bf16x8){l3[0], l3[1], l3[2], l3[3], h3[0], h3[1], h3[2], h3[3]}, o[d0], 0, 0, 0); } while (0)
    PV_D0(0); PV_D0(1); PV_D0(2); PV_D0(3);
#undef PV_D0
#undef TRRD
}

template <class TIn, class TOut> struct BlockRef { const TIn* Q; const TIn* K; const TIn* V; TOut* O; int P0; };
template <class TIn> struct Seam {
    bf16x8 qr[8];
    bf16x8 st_v0, st_v1, st_k0, st_k1; f32x4 sf0, sf1, sf2, sf3;
    f32x4 tq[16];
};
__device__ __forceinline__ int swa_jlo(int P0, int W) { const int lowk = P0 - W + 1; return lowk > 0 ? lowk / KVBLK : 0; }
#define ROW(p, k0, rr) ((p) + (size_t)((k0) + (rr)) * D + sc)
#define VMW() asm volatile("s_waitcnt vmcnt(0)" ::: "memory")
#define VMWN(n) asm volatile("s_waitcnt vmcnt(%0)" :: "i"(n) : "memory")
#define SLOAD_H(Kp, Vp, k0) do { S.st_v0 = load8<TIn>(ROW(Vp, k0, sr)); S.st_v1 = load8<TIn>(ROW(Vp, k0, 32 + sr));              \
                         S.st_k0 = load8<TIn>(ROW(Kp, k0, sr)); S.st_k1 = load8<TIn>(ROW(Kp, k0, 32 + sr)); } while (0)
#define SWRITE_HK(bf) do { *(bf16x8*)(K_lds + (bf) * SHM_K + kws) = S.st_k0; *(bf16x8*)(K_lds + (bf) * SHM_K + kws + 32 * 256) = S.st_k1; } while (0)
#define SWRITE_HV(bf) do { *(bf16x8*)(V_lds + (bf) * SHM_V + vst0) = S.st_v0; *(bf16x8*)(V_lds + (bf) * SHM_V + vst1) = S.st_v1; } while (0)
#define SWRITE_H(bf) do { SWRITE_HV(bf); SWRITE_HK(bf); } while (0)
#define SLOAD_F(p, k0) do { S.sf0 = *(const f32x4*)ROW(p, k0, sr); S.sf1 = *(const f32x4*)(ROW(p, k0, sr) + 4);                \
                            S.sf2 = *(const f32x4*)ROW(p, k0, 32 + sr); S.sf3 = *(const f32x4*)(ROW(p, k0, 32 + sr) + 4); } while (0)
#define SWRITE_KF(bf) do { *(bf16x8*)(K_lds + (bf) * SHM_K + kws) = pack8(S.sf0, S.sf1); *(bf16x8*)(K_lds + (bf) * SHM_K + kws + 32 * 256) = pack8(S.sf2, S.sf3); } while (0)
#define SWRITE_VF(bf) do { *(bf16x8*)(V_lds + (bf) * SHM_V + vst0) = pack8(S.sf0, S.sf1); *(bf16x8*)(V_lds + (bf) * SHM_V + vst1) = pack8(S.sf2, S.sf3); } while (0)
template <class TIn, class TOut>
__device__ __forceinline__ void causal_swa_prime(const BlockRef<TIn, TOut>& cur, int W, char* lds, Seam<TIn>& S) {
    constexpr bool F32 = same_t<TIn, float>::v;
    const int tid = threadIdx.x, wid = __builtin_amdgcn_readfirstlane(tid >> 6), lane = tid & 63, r32 = lane & 31, hi = lane >> 5;
    const int sr = tid >> 4, sc = (tid & 15) * 8, kws = KSWZ(sr, sc * 2); char* K_lds = lds + 2 * SHM_V;
    const int kb0 = swa_jlo(cur.P0, W) * KVBLK;
    for (int d0 = 0; d0 < 8; ++d0) S.qr[d0] = load8<TIn>(cur.Q + (size_t)(wid * QBLK + r32) * D + d0 * 16 + hi * 8);
    if constexpr (F32) { SLOAD_F((const float*)cur.K, kb0); VMW(); SWRITE_KF(0); SBAR(); SLOAD_F((const float*)cur.V, kb0); }
    else { SLOAD_H(cur.K, cur.V, kb0); VMW(); SWRITE_HK(0); }
    __syncthreads();
}
template <class TIn, class TOut>
__device__ __forceinline__ void causal_swa_block(const BlockRef<TIn, TOut>& cur, const BlockRef<TIn, TOut>& nxt, int skv, int W, char* lds, Seam<TIn>& S) {
    constexpr bool F32 = same_t<TIn, float>::v;
    const int tid = threadIdx.x, wid = __builtin_amdgcn_readfirstlane(tid >> 6), lane = tid & 63, r32 = lane & 31, hi = lane >> 5;
    const int j_lo = swa_jlo(cur.P0, W);
    int j_hi = (cur.P0 + QB - 1) / KVBLK + 1; if (j_hi > skv / KVBLK) j_hi = skv / KVBLK;
    const int NT = j_hi - j_lo;
    const int kbn = swa_jlo(nxt.P0, W) * KVBLK;
    const int qlo = cur.P0 + wid * QBLK, qm = qlo + r32 - 4 * hi;
    char* V_lds = lds; char* K_lds = lds + 2 * SHM_V;
    float* ws = (float*)(lds + 2 * SHM_V + 2 * SHM_K) + wid * 64; float* li_l = ws, * al_l = ws + 32;
    float m_reg = -1e30f, l_reg = 0; f32x16 o[4] = {};
    const int sr = tid >> 4, sc = (tid & 15) * 8, vst0 = v_st(sr, sc), vst1 = v_st(32 + sr, sc), kws = KSWZ(sr, sc * 2);
    const int vb0 = (int)(uintptr_t)V_lds + v_rd_base(lane);
    const TIn* Kh = cur.K; const TIn* Vh = cur.V;
#define RESC(a) do { if (__any((a) < 1.f)) { if (hi == 0) al_l[r32] = (a); asm volatile("s_waitcnt lgkmcnt(0)" ::: "memory");              \
                     for (int d_ = 0; d_ < 4; ++d_) for (int r = 0; r < 16; ++r) o[d_][r] *= al_l[crow(r, hi)]; } } while (0)
#define KBASE(t) ((j_lo + (t)) * KVBLK)
#define ACT(t) (KBASE(t) <= qlo + QBLK - 1 && KBASE(t) + KVBLK - 1 >= qlo - W + 1)
#define MASKT(P0_, P1_, t) do { const int kb_ = KBASE(t); if ((!SK || ACT(t)) && (kb_ + KVBLK - 1 > qlo || kb_ <= qlo + QBLK - 1 - W)) mask_tile(P0_, P1_, qm - kb_, (unsigned)W); } while (0)
    constexpr int NQL = F32 ? 16 : 8;
    constexpr bool SK = WSKIP && !F32;
#define SEAM_K0() do { VMWN(NQL); if constexpr (F32) { SWRITE_KF(0); SBAR(); SLOAD_F((const float*)nxt.V, kbn); } else { SWRITE_HK(0); } SBAR(); } while (0)
    f32x16 pA0, pA1, pB0, pB1; float mnA, mnB, alA, alB; bf16x8 pa0, pa1, pa2, pa3;
    if constexpr (F32) { VMW(); SWRITE_VF(0); SBAR(); } else { SWRITE_HV(0); SBAR(); }
    if (NT > 1) { if constexpr (F32) SLOAD_F((const float*)Kh, KBASE(1)); else SLOAD_H(Kh, Vh, KBASE(1)); }
    SBAR(); qkt<0, SK>(pA0, pA1, K_lds, r32, hi, S.qr, ACT(0));
    if constexpr (F32) { if (NT > 1) { VMW(); SWRITE_KF(1); SBAR(); SLOAD_F((const float*)Vh, KBASE(1)); } }
    MASKT(pA0, pA1, 0); partialSM(pA0, pA1, m_reg, mnA, alA);
    if (NT > 1) { VMW(); if constexpr (F32) { SWRITE_VF(1); SBAR(); if (NT > 2) SLOAD_F((const float*)Kh, KBASE(2)); } else SWRITE_H(1); }
    __syncthreads();
#define HALF_STEP(PX0, PX1, mnX, alX, PY0, PY1, alY, t, KB, VB, SB) do {                                                      \
        SBAR(); qkt<KB, SK>(PX0, PX1, K_lds, r32, hi, S.qr, ACT(t));                                             \
        finishSM(PY0, PY1, alY, l_reg, pa0, pa1, pa2, pa3); SBAR();                                                           \
        if ((t) + 1 < NT) { if constexpr (F32) { VMW(); SWRITE_KF(SB); SBAR(); SLOAD_F((const float*)Vh, KBASE((t) + 1)); }  \
                            else { SLOAD_H(Kh, Vh, KBASE((t) + 1)); } SBAR(); }                                               \
        pv_tile<VB, SK>(o, vb0, pa0, pa1, pa2, pa3, ACT((t) - 1)); MASKT(PX0, PX1, (t)); partialSM(PX0, PX1, m_reg, mnX, alX);                                        \
        __syncthreads();                                                                                                      \
        if ((t) + 1 < NT) { VMW(); if constexpr (F32) { SWRITE_VF(SB); SBAR(); if ((t) + 2 < NT) SLOAD_F((const float*)Kh, KBASE((t) + 2)); } \
                            else { SWRITE_H(SB); } }                                                                          \
        RESC(alX); __syncthreads(); } while (0)
    for (int t = 1; t + 1 < NT; t += 2) {
        HALF_STEP(pB0, pB1, mnB, alB, pA0, pA1, alA, t, 1, 0, 0);
        HALF_STEP(pA0, pA1, mnA, alA, pB0, pB1, alB, t + 1, 0, 1, 1);
    }
    const bool even = (NT & 1) == 0;
    if (even) { SBAR(); qkt<1, SK>(pB0, pB1, K_lds, r32, hi, S.qr, ACT(NT - 1)); SBAR(); }
#define QROW(e) (nxt.Q + (size_t)(wid * QBLK + r32) * D + ((e) >> 1) * 16 + hi * 8 + ((e) & 1) * 4)
    if constexpr (F32) { SLOAD_F((const float*)nxt.K, kbn); SBAR();
#pragma unroll
        for (int e = 0; e < 8; ++e) S.tq[e] = *(const f32x4*)QROW(e); }
    else { SLOAD_H(nxt.K, nxt.V, kbn); SBAR();
#pragma unroll
        for (int d0 = 0; d0 < 8; ++d0) S.qr[d0] = load8<TIn>(nxt.Q + (size_t)(wid * QBLK + r32) * D + d0 * 16 + hi * 8); }
    SBAR();
    finishSM(pA0, pA1, alA, l_reg, pa0, pa1, pa2, pa3); SBAR();
    if constexpr (F32) {
#pragma unroll
        for (int e = 8; e < 16; ++e) S.tq[e] = *(const f32x4*)QROW(e); SBAR(); }
#undef QROW
    pv_tile<0, SK>(o, vb0, pa0, pa1, pa2, pa3, ACT(even ? NT - 2 : NT - 1));
    if (even) { MASKT(pB0, pB1, NT - 1); partialSM(pB0, pB1, m_reg, mnB, alB); __syncthreads(); RESC(alB);
        finishSM(pB0, pB1, alB, l_reg, pa0, pa1, pa2, pa3); SBAR(); pv_tile<1, SK>(o, vb0, pa0, pa1, pa2, pa3, ACT(NT - 1)); }
    SBAR(); SEAM_K0();
    if (hi == 0) li_l[r32] = l_reg; asm volatile("s_waitcnt lgkmcnt(0)" ::: "memory");
    float rli[16];
#pragma unroll
    for (int r = 0; r < 16; ++r) rli[r] = __builtin_amdgcn_rcpf(li_l[crow(r, hi)]);
    TOut* Ow = cur.O + (size_t)(wid * QBLK) * D;
#pragma unroll
    for (int r = 0; r < 16; ++r) { const int orow = crow(r, hi);
#pragma unroll
        for (int d0 = 0; d0 < 4; ++d0) { const float v = o[d0][r] * rli[r];
            if constexpr (same_t<TOut, float>::v) { Ow[(size_t)orow * D + d0 * 32 + r32] = v; }
            else { const float vn = __shfl_xor(v, 1);
                   if ((r32 & 1) == 0) *(unsigned*)(Ow + (size_t)orow * D + d0 * 32 + r32) = cvtpk(v, vn); } } }
    if constexpr (F32) {
#pragma unroll
        for (int d0 = 0; d0 < 8; ++d0) S.qr[d0] = pack8(S.tq[2 * d0], S.tq[2 * d0 + 1]); }
    __syncthreads();
#undef RESC
#undef KBASE
#undef ACT
#undef MASKT
#undef SEAM_K0
#undef HALF_STEP
}
#undef ROW
#undef VMW
#undef VMWN
#undef SLOAD_H
#undef SWRITE_HK
#undef SWRITE_HV
#undef SWRITE_H
#undef SLOAD_F
#undef SWRITE_KF
#undef SWRITE_VF

__host__ __device__ inline int swa_nramp(int nqb, int W, int qoff) { const int t = W - 1 - qoff; const int n = t < 0 ? 0 : t / QB + 1; return n > nqb ? nqb : n; }
__host__ __device__ inline int swa_nx(int nqb, int nramp, int order) { return (order & ORDER_PAIRED) ? (nramp + 1) / 2 + (nqb - nramp) : nqb; }
struct SwaItem { int bh, qb0, qb1; };
__device__ __forceinline__ SwaItem swa_decode(int L, int nb, int nh, int nhkv, int nqb, int nx, int nramp, int order) {
    const int G = nh / nhkv; SwaItem it; int x;
    if ((order & ORDER_XCD) && (nb * nhkv) % 8 == 0) { const int xcd = L & 7, k = L >> 3, per = G * nx, gi = k / per, r = k - gi * per;
        it.bh = (gi * 8 + xcd) * G + r / nx; x = r % nx; }
    else { it.bh = L / nx; x = L - it.bh * nx; }
    if (order & ORDER_PAIRED) { const int ns = nqb - nramp;
        if (x < ns) { it.qb0 = it.qb1 = nqb - 1 - x; } else { it.qb0 = x - ns; it.qb1 = nramp - 1 - it.qb0; } }
    else { it.qb0 = it.qb1 = ((order & 3) == ORDER_REVERSED) ? nqb - 1 - x : x; }
    return it;
}
}

namespace att2 {
using att::bf16; using att::bf16x8; using att::f32x16; using att::QBLK; using att::QB; using att::KVBLK;
constexpr int KSLOT = 16384, VBASE = 32768, VSLOT = 32768, WSF_OFF = 131072 + 1024, LDS_NEED = WSF_OFF + 8 * 64 * 4;
__device__ __forceinline__ void glds16s(const char* sbase, unsigned voff, unsigned lds_dst) { unsigned keep;
    asm volatile("s_mov_b32 %0, m0\n\ts_mov_b32 m0, %3\n\ts_nop 0\n\tglobal_load_lds_dwordx4 %1, %2\n\ts_mov_b32 m0, %0" : "=&s"(keep) : "v"(voff), "s"(sbase), "s"(lds_dst) : "memory"); }
#define A2_WAIT_BAR() asm volatile("s_waitcnt vmcnt(0) lgkmcnt(0)\n\ts_barrier" ::: "memory")
#define A2_DSR128(dst, addr, off) asm volatile("ds_read_b128 %0, %1 offset:%2" : "=&v"(dst) : "v"(addr), "i"(off) : "memory")
#define A2_TRRD(dst, addr, off) asm volatile("ds_read_b64_tr_b16 %0, %1 offset:%2" : "=&v"(dst) : "v"(addr), "i"(off) : "memory")
#define A2_LGKM(n) asm volatile("s_waitcnt lgkmcnt(%0)" :: "i"(n) : "memory")
#define A2_SB() __builtin_amdgcn_sched_barrier(0)
template <int KOFF> __device__ __forceinline__ void qkt_pipe(f32x16& p0, f32x16& p1, const int (&ka)[4], const bf16x8* qr) {
    bf16x8 kf[6];
#define A2_KRD(g) do { A2_DSR128(kf[((g) % 3) * 2], ka[(g) & 3], KOFF + ((g) >> 2) * 128); A2_DSR128(kf[((g) % 3) * 2 + 1], ka[(g) & 3], KOFF + ((g) >> 2) * 128 + 8192); } while (0)
    A2_KRD(0); A2_KRD(1);
    p0 = f32x16{}; p1 = f32x16{};
#pragma unroll
    for (int g = 0; g < 8; ++g) {
        if (g + 2 < 8) { A2_KRD(g + 2); A2_LGKM(4); } else if (g + 1 < 8) { A2_LGKM(2); } else { A2_LGKM(0); }
        A2_SB();
        p0 = __builtin_amdgcn_mfma_f32_32x32x16_bf16(kf[(g % 3) * 2], qr[g], p0, 0, 0, 0);
        p1 = __builtin_amdgcn_mfma_f32_32x32x16_bf16(kf[(g % 3) * 2 + 1], qr[g], p1, 0, 0, 0);
        A2_SB();
    }
#undef A2_KRD
}
__device__ __forceinline__ void pv_pipe(f32x16* o, int vbx, bf16x8 pa0, bf16x8 pa1, bf16x8 pa2, bf16x8 pa3) {
    att::s16x4 vl[2][4], vh[2][4];
#define A2_VRD(g) do { _Pragma("unroll") for (int ks = 0; ks < 4; ++ks) { A2_TRRD(vl[(g) & 1][ks], vbx, ((g) >> 2) * 16384 + ((g) & 3) * 512 + ks * 4096); A2_TRRD(vh[(g) & 1][ks], vbx, ((g) >> 2) * 16384 + ((g) & 3) * 512 + ks * 4096 + 2048); } } while (0)
#define A2_VF(b, k) (bf16x8){vl[b][k][0], vl[b][k][1], vl[b][k][2], vl[b][k][3], vh[b][k][0], vh[b][k][1], vh[b][k][2], vh[b][k][3]}
    A2_VRD(0);
#pragma unroll
    for (int g = 0; g < 8; ++g) {
        if (g + 1 < 8) { A2_VRD(g + 1); A2_LGKM(8); } else { A2_LGKM(0); }
        A2_SB();
        o[g] = __builtin_amdgcn_mfma_f32_32x32x16_bf16(pa0, A2_VF(g & 1, 0), o[g], 0, 0, 0);
        o[g] = __builtin_amdgcn_mfma_f32_32x32x16_bf16(pa1, A2_VF(g & 1, 1), o[g], 0, 0, 0);
        o[g] = __builtin_amdgcn_mfma_f32_32x32x16_bf16(pa2, A2_VF(g & 1, 2), o[g], 0, 0, 0);
        o[g] = __builtin_amdgcn_mfma_f32_32x32x16_bf16(pa3, A2_VF(g & 1, 3), o[g], 0, 0, 0);
        A2_SB();
    }
#undef A2_VRD
#undef A2_VF
}
struct Blk { const bf16* Q; const bf16* K; const bf16* V; float* O; int P0; };
__device__ __forceinline__ void dma_tile(const char* kb, const char* vb, size_t vhi_bytes, unsigned koff, unsigned voff, unsigned lds0, int wid, int ks, int vs) {
    const unsigned dk = (unsigned)__builtin_amdgcn_readfirstlane((int)(lds0 + ks * KSLOT + wid * 1024));
    const unsigned dv = (unsigned)__builtin_amdgcn_readfirstlane((int)(lds0 + VBASE + vs * VSLOT + wid * 1024));
    glds16s(kb, koff, dk); glds16s(kb + 32 * 256, koff, dk + 8192);
    glds16s(vb, voff, dv); glds16s(vb + 32 * 256, voff, dv + 8192);
    glds16s(vb + vhi_bytes, voff, dv + 16384); glds16s(vb + vhi_bytes + 32 * 256, voff, dv + 16384 + 8192);
}
__device__ __forceinline__ void diff_attn_block(const Blk& b, size_t vhi_off, char* lds, int& vs) {
    const int tid = threadIdx.x, wid = __builtin_amdgcn_readfirstlane(tid >> 6), lane = tid & 63, r32 = lane & 31, hi = lane >> 5;
    const int NT = (b.P0 + QB) / KVBLK;
    const int qlo = b.P0 + wid * QBLK, qm = qlo + r32 - 4 * hi;
    const unsigned lds0 = (unsigned)(uintptr_t)lds;
    float* wsf = (float*)(lds + WSF_OFF) + wid * 64; float* li_l = wsf; float* al_l = wsf + 32;
    const int krow = 4 * wid + (lane >> 4);
    const unsigned koff = (unsigned)(krow * 128 + (((lane & 15) ^ (krow & 7)) * 8)) * 2u;
    const int sub = 2 * wid + (lane >> 5), kk = (sub >> 2) * 8 + ((lane & 31) >> 2), vc = (sub & 3) * 32 + (lane & 3) * 8, vk = (kk & ~0xC) | ((kk & 4) << 1) | ((kk & 8) >> 1);
    const unsigned voff = (unsigned)(vk * 128 + vc) * 2u;
    const char* kp = (const char*)b.K; const char* vp = (const char*)b.V;
    const size_t vhi_bytes = vhi_off * 2;
    int vs_prev = vs, vs_cur = vs, vs_next = (vs == 2) ? 0 : vs + 1;
    dma_tile(kp, vp, vhi_bytes, koff, voff, lds0, wid, 0, vs_cur);
    bf16x8 qr[8];
#pragma unroll
    for (int d0 = 0; d0 < 8; ++d0) qr[d0] = att::load8<bf16>(b.Q + (size_t)(wid * QBLK + r32) * 128 + d0 * 16 + hi * 8);
    float m_reg = -1e30f, l_reg = 0.f; f32x16 o[8] = {};
    const int vb0 = (int)lds0 + VBASE + att::v_rd_base(lane);
    int ka[4];
#pragma unroll
    for (int dd = 0; dd < 4; ++dd) ka[dd] = (int)lds0 + KSWZ(r32, (dd * 16 + hi * 8) * 2);
#define A2_ROT() do { vs_prev = vs_cur; vs_cur = vs_next; vs_next = (vs_next == 2) ? 0 : vs_next + 1; } while (0)
#define A2_DMA(KS, t) do { if ((t) + 1 < NT) dma_tile(kp + (size_t)((t) + 1) * (KVBLK * 256), vp + (size_t)((t) + 1) * (KVBLK * 256), vhi_bytes, koff, voff, lds0, wid, (KS) ^ 1, vs_next); } while (0)
#define A2_QKSM(KS, t) do { f32x16 p0, p1; float mn; \
        qkt_pipe<(KS) * KSLOT>(p0, p1, ka, qr); \
        { const int kb_ = (t) * KVBLK; if (kb_ + KVBLK - 1 > qlo) att::mask_tile(p0, p1, qm - kb_, 0x40000000u); } \
        att::partialSM(p0, p1, m_reg, mn, alpha); \
        att::finishSM(p0, p1, alpha, l_reg, pa0, pa1, pa2, pa3); } while (0)
#define A2_PV(VS) do { \
        if (__any(alpha < 1.f)) { if (hi == 0) al_l[r32] = alpha; asm volatile("s_waitcnt lgkmcnt(0)" ::: "memory"); \
            _Pragma("unroll") for (int d_ = 0; d_ < 8; ++d_) _Pragma("unroll") for (int r = 0; r < 16; ++r) o[d_][r] *= al_l[att::crow(r, hi)]; } \
        __builtin_amdgcn_sched_barrier(0); \
        { const int vbx = vb0 + (VS) * VSLOT; \
          pv_pipe(o, vbx, pa0, pa1, pa2, pa3); } } while (0)
    float alpha = 1.f; bf16x8 pa0, pa1, pa2, pa3;
    if (wid < 4) {
        for (int t = 0; t < NT; t += 2) {
            A2_WAIT_BAR(); A2_DMA(0, t);     A2_QKSM(0, t);     A2_PV(vs_cur); A2_ROT();
            A2_WAIT_BAR(); A2_DMA(1, t + 1); A2_QKSM(1, t + 1); A2_PV(vs_cur); A2_ROT();
        }
        A2_WAIT_BAR();
    } else {
        A2_WAIT_BAR();
        A2_DMA(0, 0); A2_QKSM(0, 0); A2_WAIT_BAR(); A2_ROT();
        A2_DMA(1, 1); A2_PV(vs_prev); A2_QKSM(1, 1); A2_WAIT_BAR(); A2_ROT();
        for (int t = 2; t < NT; t += 2) {
            A2_DMA(0, t);     A2_PV(vs_prev); A2_QKSM(0, t);     A2_WAIT_BAR(); A2_ROT();
            A2_DMA(1, t + 1); A2_PV(vs_prev); A2_QKSM(1, t + 1); A2_WAIT_BAR(); A2_ROT();
        }
        A2_PV(vs_prev);
    }
    vs = vs_cur;
#undef A2_ROT
#undef A2_DMA
#undef A2_QKSM
#undef A2_PV
    if (hi == 0) li_l[r32] = l_reg; asm volatile("s_waitcnt lgkmcnt(0)" ::: "memory");
    unsigned obase = (unsigned)((wid * QBLK + 4 * hi) * 256 + r32) * 4u;
    asm volatile("" : "+v"(obase));
    char* Ob = (char*)b.O;
#pragma unroll
    for (int r = 0; r < 16; ++r) { const float rl = __builtin_amdgcn_rcpf(li_l[att::crow(r, hi)]); const unsigned roff = obase + (unsigned)((r & 3) + 8 * (r >> 2)) * 1024u;
#pragma unroll
        for (int d0 = 0; d0 < 8; ++d0) *(float*)(Ob + roff + d0 * 128) = o[d0][r] * rl; }
    asm volatile("s_waitcnt lgkmcnt(0)" ::: "memory");
}
#undef A2_WAIT_BAR
}
#undef SBAR

constexpr int NWAVES = 8;
#ifndef MK_ONE_LAUNCH
#define MK_ONE_LAUNCH 1
#endif
constexpr int N_PHASES = 10;

constexpr int MI8_TILES = 56;
constexpr float W8_CLIP_SIGMAS = 4.0f;
constexpr int NBF = 10240, NG8 = 8192;
constexpr int S = 8192, DM = 4096, NIN = 18432, DFF = 16384, NHEAD = 8, AW = 2048, SGW = 2048, NGRP = 8, CHUNK = 128;
constexpr float LN_EPS = 1e-5f;
constexpr float ALPHA = 1.189207115002721f;
constexpr float LAMBDA_INIT = 0.2f;

constexpr size_t MiB = 1u << 20;
constexpr size_t WS_CTL = 0, CTL_ZERO_BYTES = 64 * 1024;
constexpr size_t WS_ROPE = 1 * MiB;
constexpr size_t WS_RS = 3 * MiB;
constexpr size_t WS_STATS = 2 * MiB;
constexpr size_t WS_WIN_T = 4 * MiB;
constexpr size_t WS_OPART = WS_WIN_T;
constexpr size_t WS_H1B = WS_WIN_T;
constexpr size_t WS_WPA_T = 148 * MiB, WS_WPS_T = 164 * MiB;
constexpr size_t WS_WOUT_T = 180 * MiB;
constexpr size_t WS_WMI_T = 212 * MiB;
constexpr size_t WS_WMO_T = 340 * MiB;
constexpr size_t WS_XB = 468 * MiB;
constexpr size_t WS_YA = WS_XB, WS_YB = WS_XB + 32 * MiB;
constexpr size_t WS_Q = 532 * MiB, WS_K = 564 * MiB, WS_V = 596 * MiB;
constexpr size_t WS_MERGED = WS_Q;
constexpr size_t WS_GU = 628 * MiB, WS_GS = 660 * MiB;
constexpr size_t WS_SGA = 692 * MiB, WS_SGB = 756 * MiB;
constexpr size_t WS_R1 = WS_SGA;
constexpr size_t WS_R2 = WS_SGB;
constexpr size_t WS_Z = 820 * MiB;
constexpr size_t WS_XF8 = WS_Z;
constexpr size_t WS_WG8_T = WS_Z + 32 * MiB;
constexpr size_t WS_END = 1076 * MiB;
static_assert((size_t)MI8_TILES * 256 * 4096 <= (size_t)MI8_TILES * 256 * 4096 * 2, "int8 rows of w_mlp_in^T fit in the head of the bf16 copy");
static_assert(WS_K == WS_Q + 32 * MiB && WS_V == WS_K + 32 * MiB && WS_GS == WS_GU + 32 * MiB && WS_SGB == WS_SGA + 64 * MiB, "EpiProj's section strides");
constexpr int CW_BAR = 1024;

constexpr int RING_OFF = 0, RING_BYTES = 131072;
constexpr int LDSCTL_OFF = RING_BYTES, MISC_OFF = LDSCTL_OFF + 320;
constexpr int LDS_BYTES = 147456;
static_assert(MISC_OFF + 128 <= LDS_BYTES && MISC_OFF + 128 <= att2::WSF_OFF && att2::LDS_NEED <= LDS_BYTES, "LDS map");

#define GAS __attribute__((address_space(1)))
#define LAS __attribute__((address_space(3)))
typedef unsigned short bf16;
typedef unsigned v4u __attribute__((ext_vector_type(4)));
typedef unsigned v2u __attribute__((ext_vector_type(2)));
typedef float f32x4 __attribute__((ext_vector_type(4)));
typedef float f32x2 __attribute__((ext_vector_type(2)));
typedef float f32x16 __attribute__((ext_vector_type(16)));
typedef short bf16x8 __attribute__((ext_vector_type(8)));
typedef GAS unsigned gu32;
#define RLX_AGENT __ATOMIC_RELAXED, __HIP_MEMORY_SCOPE_AGENT
#define LDS_WAIT() asm volatile("s_waitcnt lgkmcnt(0)" ::: "memory")
#define VM_WAIT() asm volatile("s_waitcnt vmcnt(0)" ::: "memory")
__device__ __forceinline__ unsigned pk2(float lo, float hi) { return pg8::cvt_pk_bf16(lo, hi); }
__device__ __forceinline__ float bflo(unsigned w) { return __uint_as_float(w << 16); }
__device__ __forceinline__ float bfhi(unsigned w) { return __uint_as_float(w & 0xffff0000u); }

#define XB_TMO      128
#define XB_XCNT(j)  (256  + 64 * (j))
#define XB_XSUB(j)  (1280 + 64 * (j))
#define XB_XGEN(j)  (2304 + 64 * (j))
#define XB_TOP      3328
#define XB_TOPGEN   3392
#define XCD_BAR_WORDS 3456
#define XB_SPIN_CAP (1u << 18)

__device__ __forceinline__ unsigned xb_ld(unsigned* p)              { return __hip_atomic_load(p, __ATOMIC_RELAXED, __HIP_MEMORY_SCOPE_AGENT); }
__device__ __forceinline__ unsigned xb_add(unsigned* p, unsigned v) { return __hip_atomic_fetch_add(p, v, __ATOMIC_RELAXED, __HIP_MEMORY_SCOPE_AGENT); }
__device__ __forceinline__ unsigned xb_xcc_id() { return (unsigned)__builtin_amdgcn_s_getreg((3 << 11) | 20) & 0xFu; }
#define XB_SPIN(cond, bar) do { unsigned _sp = 0; while (cond) { __builtin_amdgcn_s_sleep(1); \
    if ((++_sp & 255u) == 0u) { if (xb_ld(&(bar)[XB_TMO])) break; if (_sp > XB_SPIN_CAP) { atomicAdd(&(bar)[XB_TMO], 1u); break; } } } } while (0)

struct XcdBarrier {
    unsigned* bar; unsigned x;
    volatile LAS unsigned* st;
};

__device__ __forceinline__ XcdBarrier xcd_barrier_post(unsigned* bar, volatile LAS unsigned* st) {
    XcdBarrier b; b.bar = bar; b.x = xb_xcc_id(); b.st = st;
    if (threadIdx.x == 0) (void)xb_add(&bar[XB_XCNT(b.x)], 1u);
    return b;
}
__device__ __forceinline__ void xcd_barrier_complete(unsigned* bar, unsigned x, unsigned& nloc, unsigned& nx) {
    const unsigned G = gridDim.x * gridDim.y * gridDim.z;
    unsigned sum, cnt, mine, sp = 0u;
    for (;;) {
        sum = 0u; cnt = 0u; mine = 0u;
#pragma unroll
        for (unsigned j = 0; j < 16; ++j) { const unsigned c = xb_ld(&bar[XB_XCNT(j)]); sum += c; cnt += (c > 0u) ? 1u : 0u; mine = (j == x) ? c : mine; }
        if (sum == G) break;
        __builtin_amdgcn_s_sleep(1);
        if ((++sp & 255u) == 0u) { if (xb_ld(&bar[XB_TMO])) break; if (sp > XB_SPIN_CAP) { atomicAdd(&bar[XB_TMO], 1u); break; } }
    }
    nloc = mine > 0u ? mine : 1u; nx = cnt > 0u ? cnt : 1u;
}

__device__ __forceinline__ void xcd_barrier(const XcdBarrier& b) {
    asm volatile("s_waitcnt vmcnt(0)" ::: "memory");
    __syncthreads();
    if (threadIdx.x == 0) {
        unsigned* bar = b.bar;
        __builtin_amdgcn_s_waitcnt(0);
        unsigned nloc = b.st[0], nx = b.st[1];
        if (nloc == 0u) { xcd_barrier_complete(bar, b.x, nloc, nx); b.st[0] = nloc; b.st[1] = nx; }
        const unsigned old = xb_add(&bar[XB_XSUB(b.x)], 1u);
        const unsigned gen = old / nloc;
        if (old + 1u == (gen + 1u) * nloc) {
            __builtin_amdgcn_fence(__ATOMIC_RELEASE, "agent");
            asm volatile("s_waitcnt vmcnt(0)" ::: "memory");
            const unsigned og = xb_add(&bar[XB_TOP], 1u);
            const unsigned tg = og / nx;
            if (og + 1u == (tg + 1u) * nx) xb_add(&bar[XB_TOPGEN], 1u);
            else XB_SPIN(xb_ld(&bar[XB_TOPGEN]) == tg, bar);
            __builtin_amdgcn_fence(__ATOMIC_ACQUIRE, "agent");
            xb_add(&bar[XB_XGEN(b.x)], 1u);
            asm volatile("s_waitcnt vmcnt(0)" ::: "memory");
        } else {
            XB_SPIN(xb_ld(&bar[XB_XGEN(b.x)]) == gen, bar);
            __builtin_amdgcn_fence(__ATOMIC_ACQUIRE, "agent");
            asm volatile("s_waitcnt vmcnt(0)" ::: "memory");
        }
    }
    __syncthreads();
}


__device__ __forceinline__ float wave_sum(float v) {
#pragma unroll
    for (int o = 1; o < 64; o <<= 1) v += __shfl_xor(v, o);
    return v;
}
template <bool NT> __device__ __forceinline__ void p0_transpose_item(const float* W, int K, int N, bf16* WT, LAS float* scr, int item, int lane, int ldt = 0) {
    const int nblk = N / 32, kb = item / nblk, nb = item % nblk, k0 = 64 * kb, n0 = 32 * nb;
    float tmp[32];
#pragma unroll
    for (int i = 0; i < 32; ++i) { const int kk = 2 * i + (lane >> 5); tmp[i] = __builtin_nontemporal_load(&W[(size_t)(k0 + kk) * N + n0 + (lane & 31)]); }
#pragma unroll
    for (int i = 0; i < 32; ++i) { const int kk = 2 * i + (lane >> 5); scr[kk * 33 + (lane & 31)] = tmp[i]; }
    LDS_WAIT(); asm volatile("" ::: "memory");
    const int c = lane & 7;
#pragma unroll
    for (int j = 0; j < 4; ++j) { const int n = (lane >> 3) + 8 * j; const LAS float* s = scr + (8 * c) * 33 + n;
        v4u o; o.x = pk2(s[0 * 33], s[1 * 33]); o.y = pk2(s[2 * 33], s[3 * 33]); o.z = pk2(s[4 * 33], s[5 * 33]); o.w = pk2(s[6 * 33], s[7 * 33]);
        const size_t wo = (size_t)(n0 + n) * (ldt ? ldt : K) + k0 + 8 * c;
        if (NT) __builtin_nontemporal_store(o, (GAS v4u*)(WT + wo)); else *(GAS v4u*)(WT + wo) = o; }
    LDS_WAIT(); asm volatile("" ::: "memory");
}
__device__ __forceinline__ unsigned pk4_fp8(float a, float b, float c, float d) {
    a = fminf(fmaxf(a, -448.f), 448.f); b = fminf(fmaxf(b, -448.f), 448.f); c = fminf(fmaxf(c, -448.f), 448.f); d = fminf(fmaxf(d, -448.f), 448.f);
    int w = 0; w = __builtin_amdgcn_cvt_pk_fp8_f32(a, b, w, false); w = __builtin_amdgcn_cvt_pk_fp8_f32(c, d, w, true); return (unsigned)w; }
__device__ __forceinline__ void p0_transpose_item_f8(const float* W, int K, int N, int n0, int n0_out, int k0, unsigned char* WT, float scale, LAS float* scr, int lane) {
    float tmp[32];
#pragma unroll
    for (int i = 0; i < 32; ++i) { const int kk = 2 * i + (lane >> 5); tmp[i] = __builtin_nontemporal_load(&W[(size_t)(k0 + kk) * N + n0 + (lane & 31)]); }
#pragma unroll
    for (int i = 0; i < 32; ++i) { const int kk = 2 * i + (lane >> 5); scr[kk * 33 + (lane & 31)] = tmp[i]; }
    LDS_WAIT(); asm volatile("" ::: "memory");
    const int c = lane & 3;
#pragma unroll
    for (int j = 0; j < 2; ++j) { const int n = (lane >> 2) + 16 * j; const LAS float* s = scr + (16 * c) * 33 + n;
        v4u o; o.x = pk4_fp8(s[0 * 33] * scale, s[1 * 33] * scale, s[2 * 33] * scale, s[3 * 33] * scale); o.y = pk4_fp8(s[4 * 33] * scale, s[5 * 33] * scale, s[6 * 33] * scale, s[7 * 33] * scale);
        o.z = pk4_fp8(s[8 * 33] * scale, s[9 * 33] * scale, s[10 * 33] * scale, s[11 * 33] * scale); o.w = pk4_fp8(s[12 * 33] * scale, s[13 * 33] * scale, s[14 * 33] * scale, s[15 * 33] * scale);
        *(GAS v4u*)(WT + (size_t)(n0_out + n) * K + k0 + 16 * c) = o; }
    LDS_WAIT(); asm volatile("" ::: "memory");
}
__device__ __forceinline__ unsigned pk4_i8(float a, float b, float c, float d) {
    const int qa = (int)__builtin_rintf(fminf(fmaxf(a, -127.f), 127.f)), qb = (int)__builtin_rintf(fminf(fmaxf(b, -127.f), 127.f)), qc = (int)__builtin_rintf(fminf(fmaxf(c, -127.f), 127.f)), qd = (int)__builtin_rintf(fminf(fmaxf(d, -127.f), 127.f));
    return (unsigned)(qa & 0xff) | ((unsigned)(qb & 0xff) << 8) | ((unsigned)(qc & 0xff) << 16) | ((unsigned)qd << 24); }
__device__ __forceinline__ void p0_transpose_item_i8(const float* W, int K, int N, unsigned char* WT, float scale, LAS float* scr, int item, int lane) {
    const int nblk = N / 32, kb = item / nblk, nb = item % nblk, k0 = 64 * kb, n0 = 32 * nb;
    float tmp[32];
#pragma unroll
    for (int i = 0; i < 32; ++i) { const int kk = 2 * i + (lane >> 5); tmp[i] = __builtin_nontemporal_load(&W[(size_t)(k0 + kk) * N + n0 + (lane & 31)]); }
#pragma unroll
    for (int i = 0; i < 32; ++i) { const int kk = 2 * i + (lane >> 5); scr[kk * 33 + (lane & 31)] = tmp[i]; }
    LDS_WAIT(); asm volatile("" ::: "memory");
    const int c = lane & 3;
#pragma unroll
    for (int j = 0; j < 2; ++j) { const int n = (lane >> 2) + 16 * j; const LAS float* q = scr + (16 * c) * 33 + n;
        v4u o; o.x = pk4_i8(q[0 * 33] * scale, q[1 * 33] * scale, q[2 * 33] * scale, q[3 * 33] * scale); o.y = pk4_i8(q[4 * 33] * scale, q[5 * 33] * scale, q[6 * 33] * scale, q[7 * 33] * scale);
        o.z = pk4_i8(q[8 * 33] * scale, q[9 * 33] * scale, q[10 * 33] * scale, q[11 * 33] * scale); o.w = pk4_i8(q[12 * 33] * scale, q[13 * 33] * scale, q[14 * 33] * scale, q[15 * 33] * scale);
        *(GAS v4u*)(WT + (size_t)(n0 + n) * K + k0 + 16 * c) = o; }
    LDS_WAIT(); asm volatile("" ::: "memory");
}
__device__ __forceinline__ void ln_row_4096(const float* xrow, float* orow, bf16* obrow, const float* g, const float* b, int lane) {
    const GAS f32x4* xr = (const GAS f32x4*)xrow + lane;
    f32x4 v[16]; float s = 0.f;
#pragma unroll
    for (int j = 0; j < 16; ++j) { v[j] = xr[64 * j]; s += (v[j].x + v[j].y) + (v[j].z + v[j].w); }
    const float mean = wave_sum(s) * (1.f / 4096.f); float s2 = 0.f;
#pragma unroll
    for (int j = 0; j < 16; ++j) { v[j] = v[j] - mean; s2 += (v[j].x * v[j].x + v[j].y * v[j].y) + (v[j].z * v[j].z + v[j].w * v[j].w); }
    const float rstd = 1.f / sqrtf(wave_sum(s2) * (1.f / 4096.f) + LN_EPS);
#pragma unroll
    for (int j = 0; j < 16; ++j) { const int c4 = 64 * j + lane; const f32x4 gg = ((const GAS f32x4*)g)[c4], bb = ((const GAS f32x4*)b)[c4];
        const f32x4 y = v[j] * rstd * gg + bb;
        ((GAS f32x4*)orow)[c4] = y;
        if (obrow) { v2u w; w.x = pk2(y.x, y.y); w.y = pk2(y.z, y.w); ((GAS v2u*)obrow)[c4] = w; } }
}

__device__ __forceinline__ void ln_row_4096_b(const bf16* xrow, float* orow, bf16* obrow, const float* g, const float* b, int lane) {
    const GAS v4u* xr = (const GAS v4u*)xrow + lane;
    float v[64]; float s = 0.f;
#pragma unroll
    for (int j = 0; j < 8; ++j) { const v4u w = xr[64 * j];
        v[8 * j + 0] = bflo(w.x); v[8 * j + 1] = bfhi(w.x); v[8 * j + 2] = bflo(w.y); v[8 * j + 3] = bfhi(w.y);
        v[8 * j + 4] = bflo(w.z); v[8 * j + 5] = bfhi(w.z); v[8 * j + 6] = bflo(w.w); v[8 * j + 7] = bfhi(w.w); }
#pragma unroll
    for (int e = 0; e < 64; ++e) s += v[e];
    const float mean = wave_sum(s) * (1.f / 4096.f); float s2 = 0.f;
#pragma unroll
    for (int e = 0; e < 64; ++e) { v[e] -= mean; s2 += v[e] * v[e]; }
    const float rstd = 1.f / sqrtf(wave_sum(s2) * (1.f / 4096.f) + LN_EPS);
#pragma unroll
    for (int j = 0; j < 8; ++j) { const int c8 = 64 * j + lane;
        const f32x4 g0 = ((const GAS f32x4*)g)[2 * c8], g1 = ((const GAS f32x4*)g)[2 * c8 + 1], b0 = ((const GAS f32x4*)b)[2 * c8], b1 = ((const GAS f32x4*)b)[2 * c8 + 1];
        const f32x4 y0 = (f32x4){v[8 * j + 0], v[8 * j + 1], v[8 * j + 2], v[8 * j + 3]} * rstd * g0 + b0, y1 = (f32x4){v[8 * j + 4], v[8 * j + 5], v[8 * j + 6], v[8 * j + 7]} * rstd * g1 + b1;
        if (obrow) ((GAS v4u*)obrow)[c8] = pg8::pack8(y0, y1);
        else { ((GAS f32x4*)orow)[2 * c8] = y0; ((GAS f32x4*)orow)[2 * c8 + 1] = y1; } }
}

__device__ __forceinline__ void ln_row_4096_bf(const bf16* xrow, float* orow, const float* g, const float* b, int lane) {
    const GAS v2u* xr = (const GAS v2u*)xrow + lane;
    f32x4 v[16]; float s = 0.f;
#pragma unroll
    for (int j = 0; j < 16; ++j) { const v2u w = xr[64 * j]; v[j] = (f32x4){bflo(w.x), bfhi(w.x), bflo(w.y), bfhi(w.y)}; s += (v[j].x + v[j].y) + (v[j].z + v[j].w); }
    const float mean = wave_sum(s) * (1.f / 4096.f); float s2 = 0.f;
#pragma unroll
    for (int j = 0; j < 16; ++j) { v[j] = v[j] - mean; s2 += (v[j].x * v[j].x + v[j].y * v[j].y) + (v[j].z * v[j].z + v[j].w * v[j].w); }
    const float rstd = 1.f / sqrtf(wave_sum(s2) * (1.f / 4096.f) + LN_EPS);
#pragma unroll
    for (int j = 0; j < 16; ++j) { const int c4 = 64 * j + lane; const f32x4 gg = ((const GAS f32x4*)g)[c4], bb = ((const GAS f32x4*)b)[c4];
        ((GAS f32x4*)orow)[c4] = v[j] * rstd * gg + bb; }
}

__device__ __forceinline__ float t8scale(const float* W, int lane) {
    float q = 0.f;
#pragma unroll
    for (int j = 0; j < 16; ++j) { const f32x4 v = ((const GAS f32x4*)W)[64 * j + lane]; q += (v.x * v.x + v.y * v.y) + (v.z * v.z + v.w * v.w); }
    q = wave_sum(q); return 127.0f / (W8_CLIP_SIGMAS * sqrtf(q * (1.0f / 4096.f)) + 1e-30f);
}
__device__ __forceinline__ void ln_row_4096_b8(const bf16* xrow, bf16* obrow, unsigned char* o8row, float* hs, float wscale, const float* g, const float* b, int lane) {
    const GAS v4u* xr = (const GAS v4u*)xrow + lane;
    float v[64]; float s = 0.f;
#pragma unroll
    for (int j = 0; j < 8; ++j) { const v4u w = xr[64 * j];
        v[8 * j + 0] = bflo(w.x); v[8 * j + 1] = bfhi(w.x); v[8 * j + 2] = bflo(w.y); v[8 * j + 3] = bfhi(w.y);
        v[8 * j + 4] = bflo(w.z); v[8 * j + 5] = bfhi(w.z); v[8 * j + 6] = bflo(w.w); v[8 * j + 7] = bfhi(w.w); }
#pragma unroll
    for (int e = 0; e < 64; ++e) s += v[e];
    const float mean = wave_sum(s) * (1.f / 4096.f); float s2 = 0.f;
#pragma unroll
    for (int e = 0; e < 64; ++e) { v[e] -= mean; s2 += v[e] * v[e]; }
    const float rstd = 1.f / sqrtf(wave_sum(s2) * (1.f / 4096.f) + LN_EPS);
    float am = 0.f;
#pragma unroll
    for (int j = 0; j < 8; ++j) { const int c8 = 64 * j + lane;
        const f32x4 g0 = ((const GAS f32x4*)g)[2 * c8], g1 = ((const GAS f32x4*)g)[2 * c8 + 1], b0 = ((const GAS f32x4*)b)[2 * c8], b1 = ((const GAS f32x4*)b)[2 * c8 + 1];
        const f32x4 y0 = (f32x4){v[8 * j + 0], v[8 * j + 1], v[8 * j + 2], v[8 * j + 3]} * rstd * g0 + b0, y1 = (f32x4){v[8 * j + 4], v[8 * j + 5], v[8 * j + 6], v[8 * j + 7]} * rstd * g1 + b1;
        ((GAS v4u*)obrow)[c8] = pg8::pack8(y0, y1);
        v[8 * j + 0] = y0.x; v[8 * j + 1] = y0.y; v[8 * j + 2] = y0.z; v[8 * j + 3] = y0.w; v[8 * j + 4] = y1.x; v[8 * j + 5] = y1.y; v[8 * j + 6] = y1.z; v[8 * j + 7] = y1.w;
        am = fmaxf(am, fmaxf(fmaxf(fmaxf(fabsf(y0.x), fabsf(y0.y)), fmaxf(fabsf(y0.z), fabsf(y0.w))), fmaxf(fmaxf(fabsf(y1.x), fabsf(y1.y)), fmaxf(fabsf(y1.z), fabsf(y1.w))))); }
#pragma unroll
    for (int o = 1; o < 64; o <<= 1) am = fmaxf(am, __shfl_xor(am, o));
    const float inv = am > 0.f ? 127.0f / am : 0.f;
#pragma unroll
    for (int j = 0; j < 8; ++j) { v2u o8; o8.x = pk4_i8(v[8 * j + 0] * inv, v[8 * j + 1] * inv, v[8 * j + 2] * inv, v[8 * j + 3] * inv); o8.y = pk4_i8(v[8 * j + 4] * inv, v[8 * j + 5] * inv, v[8 * j + 6] * inv, v[8 * j + 7] * inv);
        ((GAS v2u*)o8row)[64 * j + lane] = o8; }
    if (lane == 0) *hs = am * (1.0f / 127.0f) / wscale;
}

__device__ __forceinline__ void sgu_item(char* lds, int c, int g, const bf16* GS, const bf16* GU, const float* stats, const float* ln_g, const float* ln_b,
                                         const float* w_sp, const float* b_sp, bf16* YB) {
    const int tid = threadIdx.x, wid = __builtin_amdgcn_readfirstlane(tid >> 6), lane = tid & 63, r32 = lane & 31, hi = lane >> 5;
    const int sr = tid >> 4, sc = (tid & 15) * 8;
#pragma unroll
    for (int dh = 0; dh < 2; ++dh) {
        const int col = g * 256 + dh * 128 + sc;
        const f32x4 g0 = *(const f32x4*)(ln_g + col), g1 = *(const f32x4*)(ln_g + col + 4), b0 = *(const f32x4*)(ln_b + col), b1 = *(const f32x4*)(ln_b + col + 4);
#pragma unroll
        for (int st = 0; st < 2; ++st)
#pragma unroll
            for (int hf = 0; hf < 2; ++hf) {
                const int k = hf * 32 + sr, grow = c * CHUNK + st * 64 + k;
                const v4u raw = *(const v4u*)(GS + (size_t)grow * SGW + col);
                const f32x2 ms = *(const f32x2*)(stats + 2 * grow);
                f32x4 x0 = {bflo(raw.x), bfhi(raw.x), bflo(raw.y), bfhi(raw.y)}, x1 = {bflo(raw.z), bfhi(raw.z), bflo(raw.w), bfhi(raw.w)};
                x0 = (x0 - ms.x) * ms.y * g0 + b0; x1 = (x1 - ms.x) * ms.y * g1 + b1;
                *(v4u*)(lds + (st * 2 + dh) * 16384 + att::v_st(k, sc)) = pg8::pack8(x0, x1);
            }
    }
    __syncthreads();
    const int tb = wid & 3, dh = wid >> 2;
    f32x16 o[4] = {};
    const int vb0 = (int)(uintptr_t)lds + att::v_rd_base(lane);
#pragma unroll
    for (int st = 0; st < 2; ++st) {
        bf16x8 pa[4];
#pragma unroll
        for (int ks = 0; ks < 4; ++ks) { const int t = tb * 32 + r32, s0 = st * 64 + ks * 16 + 8 * hi;
            const float* wp = w_sp + ((size_t)g * CHUNK + t) * CHUNK + s0;
            f32x4 a = *(const f32x4*)wp, b = *(const f32x4*)(wp + 4);
#pragma unroll
            for (int e = 0; e < 4; ++e) { if (s0 + e > t) a[e] = 0.f; if (s0 + 4 + e > t) b[e] = 0.f; }
            const v4u w = pg8::pack8(a, b); pa[ks] = __builtin_bit_cast(bf16x8, w); }
        att::pv_tile<0, false>(o, vb0 + (st * 2 + dh) * 16384, pa[0], pa[1], pa[2], pa[3], true);
    }
    __syncthreads();
    { unsigned short* img = (unsigned short*)lds;
#pragma unroll
      for (int r = 0; r < 16; ++r) { const int t = tb * 32 + att::crow(r, hi); const float bs = b_sp[g * CHUNK + t];
#pragma unroll
          for (int d0 = 0; d0 < 4; ++d0) img[t * 256 + dh * 128 + d0 * 32 + r32] = (unsigned short)(pk2(o[d0][r] + bs, 0.f) & 0xffffu); }
      __syncthreads();
#pragma unroll
      for (int i = 0; i < 8; ++i) { const int pc = i * 512 + tid, t = pc >> 5, d8 = (pc & 31) * 8;
          const v4u m = *(const v4u*)(img + t * 256 + d8);
          const size_t go = (size_t)(c * CHUNK + t) * SGW + g * 256 + d8;
          const v4u u = *(const v4u*)(GU + go);
          const f32x4 y0 = {bflo(u.x) * bflo(m.x), bfhi(u.x) * bfhi(m.x), bflo(u.y) * bflo(m.y), bfhi(u.y) * bfhi(m.y)}, y1 = {bflo(u.z) * bflo(m.z), bfhi(u.z) * bfhi(m.z), bflo(u.w) * bflo(m.w), bfhi(u.w) * bfhi(m.w)};
          *(v4u*)(YB + (size_t)(c * CHUNK + t) * 4096 + 2048 + g * 256 + d8) = pg8::pack8(y0, y1); } }
    __syncthreads();
}


__device__ __forceinline__ att::BlockRef<att::bf16, float> att_ref(const att::SwaItem& it, int pass, const bf16* QH, const bf16* KH, const bf16* VH, float* OPART) {
    const int qb = pass ? it.qb1 : it.qb0, h = it.bh & 7, vh = (it.bh >> 3) & 1, c = it.bh >> 4;
    att::BlockRef<att::bf16, float> r;
    r.Q = (const att::bf16*)QH + ((size_t)(h * 2 + c) * S + (size_t)qb * att::QB) * 128;
    r.K = (const att::bf16*)KH + (size_t)(h * 2 + c) * S * 128;
    r.V = (const att::bf16*)VH + (size_t)(h * 2 + vh) * S * 128;
    r.O = OPART + ((size_t)((h * 2 + c) * 2 + vh) * S + (size_t)qb * att::QB) * 128;
    r.P0 = qb * att::QB; return r;
}

struct Args { const float* in[22]; float* out; unsigned char* ws; int ph_lo, ph_hi; };
__global__ void __launch_bounds__(NWAVES * 64, 2) mk_fwd(Args args) {
    extern __shared__ __attribute__((aligned(16))) unsigned char lds[];
    LAS unsigned char* const ldsl = (LAS unsigned char*)lds;
    volatile LAS unsigned* const MISC = (volatile LAS unsigned*)(ldsl + MISC_OFF);
    const int tid = threadIdx.x, lane = tid & 63, wave = __builtin_amdgcn_readfirstlane(tid >> 6);
    const int G = gridDim.x; const int bx = blockIdx.x; const int vcu = (G % 8 == 0) ? (bx % 8) * (G / 8) + bx / 8 : bx;
    const int gw = vcu * NWAVES + wave, NGW = G * NWAVES;
    unsigned char* const ws = args.ws;
    gu32* const ctl = (gu32*)(ws + WS_CTL);
    const float* x = args.in[0]; const float* w_in = args.in[1];
    const float* lq1 = args.in[2]; const float* lk1 = args.in[3]; const float* lq2 = args.in[4]; const float* lk2 = args.in[5];
    const float* subln_w = args.in[6]; const float* sgu_ln_g = args.in[7]; const float* sgu_ln_b = args.in[8];
    const float* w_spatial = args.in[9]; const float* b_spatial = args.in[10];
    const float* w_pa = args.in[11]; const float* w_ps = args.in[12]; const float* w_out = args.in[13];
    const float* ln1_g = args.in[14]; const float* ln1_b = args.in[15];
    const float* w_mi = args.in[16]; const float* b_mi = args.in[17]; const float* w_mo = args.in[18]; const float* b_mo = args.in[19];
    const float* ln2_g = args.in[20]; const float* ln2_b = args.in[21];
    float* const out = args.out;
    float* const rope = (float*)(ws + WS_ROPE); float* const stats = (float*)(ws + WS_STATS);
    bf16* const WIN_T = (bf16*)(ws + WS_WIN_T); float* const OPART = (float*)(ws + WS_OPART); bf16* const H1B = (bf16*)(ws + WS_H1B);
    bf16* const WPA_T = (bf16*)(ws + WS_WPA_T); bf16* const WPS_T = (bf16*)(ws + WS_WPS_T); bf16* const WOUT_T = (bf16*)(ws + WS_WOUT_T);
    bf16* const WMI_T = (bf16*)(ws + WS_WMI_T); bf16* const WMO_T = (bf16*)(ws + WS_WMO_T);
    bf16* const XB = (bf16*)(ws + WS_XB); bf16* const YA = (bf16*)(ws + WS_YA); bf16* const YB = (bf16*)(ws + WS_YB);
    bf16* const QH = (bf16*)(ws + WS_Q); bf16* const KH = (bf16*)(ws + WS_K); bf16* const VH = (bf16*)(ws + WS_V); bf16* const MERGED = (bf16*)(ws + WS_MERGED);
    bf16* const GU = (bf16*)(ws + WS_GU); bf16* const GS = (bf16*)(ws + WS_GS); bf16* const SGA = (bf16*)(ws + WS_SGA); bf16* const SGB = (bf16*)(ws + WS_SGB);
    bf16* const R1 = (bf16*)(ws + WS_R1); bf16* const R2 = (bf16*)(ws + WS_R2); bf16* const Z = (bf16*)(ws + WS_Z);
    unsigned char* const X8 = ws + WS_XB; unsigned char* const WIN8_T = ws + WS_WIN_T; float* const rsc = (float*)(ws + WS_RS); float* const h1s = (float*)(ws + WS_RS + 32768);
    unsigned char* const H18 = ws + WS_XB; unsigned char* const WMI8_T = ws + WS_WMI_T;

    for (int u = tid; u < (LDS_BYTES - LDSCTL_OFF) / 4; u += NWAVES * 64) ((LAS unsigned*)(ldsl + LDSCTL_OFF))[u] = 0u;
    __syncthreads();
    XcdBarrier bar; bar.bar = (unsigned*)(ctl + CW_BAR); bar.x = 0; bar.st = nullptr;
    if (MK_ONE_LAUNCH) bar = xcd_barrier_post((unsigned*)(ctl + CW_BAR), MISC + 8);
#define GRID_BAR() do { if (MK_ONE_LAUNCH) xcd_barrier(bar); } while (0)
    const int lo = args.ph_lo, hi = args.ph_hi;
#define IN(k) (lo <= (k) && (k) < hi)
#define BOTH(k) (IN(k) && IN((k) + 1))

    if (IN(0)) {
        LAS float* scr = (LAS float*)(ldsl + RING_OFF + wave * 16384);
        float w8s; { float q = 0.f;
#pragma unroll
            for (int j = 0; j < 16; ++j) { const f32x4 v = ((const GAS f32x4*)w_in)[64 * j + lane]; q += (v.x * v.x + v.y * v.y) + (v.z * v.z + v.w * v.w); }
            q = wave_sum(q); w8s = 127.0f / (W8_CLIP_SIGMAS * sqrtf(q * (1.0f / 4096.f)) + 1e-30f); }
        const float wmi8s = t8scale(w_mi, lane);
        constexpr int I_IN = (DM / 64) * (NIN / 32), I_PA = (AW / 64) * (DM / 32), I_PS = (SGW / 64) * (DM / 32), I_OUT = (DM / 64) * (DM / 32),
                      I_MI = (DM / 64) * (DFF / 32), I_MO = (DFF / 64) * (DM / 32);
        constexpr int NITEMS = I_IN + I_PA + I_PS + I_OUT + I_MI + I_MO;
        for (int it = gw; it < NITEMS; it += NGW) {
            int r = NITEMS - 1 - it;
            if (r < I_IN) { p0_transpose_item_i8(w_in, DM, NIN, WIN8_T, w8s, scr, r, lane); continue; } r -= I_IN;
            if (r < I_PA) { p0_transpose_item<true>(w_pa, AW, DM, WPA_T, scr, r, lane, 4096); continue; } r -= I_PA;
            if (r < I_PS) { p0_transpose_item<true>(w_ps, SGW, DM, WPA_T + 2048, scr, r, lane, 4096); continue; } r -= I_PS;
            if (r < I_OUT) { p0_transpose_item<true>(w_out, DM, DM, WOUT_T, scr, r, lane); continue; } r -= I_OUT;
            if (r < I_MI) { const int nb = r % (DFF / 32);
                if (nb < MI8_TILES * 8) p0_transpose_item_i8(w_mi, DM, DFF, WMI8_T, wmi8s, scr, r, lane);
                else p0_transpose_item<true>(w_mi, DM, DFF, WMI_T, scr, r, lane);
                continue; } r -= I_MI;
            p0_transpose_item<true>(w_mo, DFF, DM, WMO_T, scr, r, lane);
        }
        {
            for (int row = gw; row < S; row += NGW) { const GAS f32x4* xr = (const GAS f32x4*)(x + (size_t)row * DM) + lane; f32x4 v[16]; float am = 0.f;
#pragma unroll
                for (int j = 0; j < 16; ++j) { v[j] = __builtin_nontemporal_load(&xr[64 * j]); am = fmaxf(fmaxf(am, fmaxf(fabsf(v[j].x), fabsf(v[j].y))), fmaxf(fabsf(v[j].z), fabsf(v[j].w))); }
#pragma unroll
                for (int o = 1; o < 64; o <<= 1) am = fmaxf(am, __shfl_xor(am, o));
                const float inv = am > 0.f ? 127.0f / am : 0.f;
#pragma unroll
                for (int j = 0; j < 16; ++j) ((GAS unsigned*)(X8 + (size_t)row * DM))[64 * j + lane] = pk4_i8(v[j].x * inv, v[j].y * inv, v[j].z * inv, v[j].w * inv);
                if (lane == 0) rsc[row] = am * (1.0f / 127.0f) / w8s; }
        }
        {
            for (int i = gw * 64 + lane; i < S * 16; i += NGW * 64) { const int pos = i >> 4, j = i & 15;
                double f = 1.0; for (int q = 0; q < j; ++q) f *= 0.44036660267178046;
                const double rev = (double)pos * f * 0.15915494309189535; const float fr = (float)(rev - __builtin_floor(rev));
                f32x2 cs; cs.x = __builtin_amdgcn_cosf(fr); cs.y = __builtin_amdgcn_sinf(fr); ((GAS f32x2*)rope)[i] = cs; }
        }
        if (BOTH(0)) GRID_BAR();
    }

    if (IN(1)) {
        { pg8::Gemm g{(const bf16*)X8, (const bf16*)WIN8_T, S, NIN, DM}; pg8::StaticOrder so; so.init(S, NIN, G, bx);
          pg8::EpiProj E{QH, GU, SGA, rope, rsc};
          pg8::gemm_phase<pg8::EpiProj, pg8::StaticOrder, true, true, false, true>(ldsl + RING_OFF, g, so, E); }
        if (BOTH(1)) GRID_BAR();
    }

    if (IN(2)) {
        for (int row = gw; row < S; row += NGW) {
            const GAS v4u* p = (const GAS v4u*)(GS + (size_t)row * SGW) + lane; float v[32]; float s = 0.f;
#pragma unroll
            for (int j = 0; j < 4; ++j) { const v4u w = p[64 * j];
                v[8 * j + 0] = bflo(w.x); v[8 * j + 1] = bfhi(w.x); v[8 * j + 2] = bflo(w.y); v[8 * j + 3] = bfhi(w.y);
                v[8 * j + 4] = bflo(w.z); v[8 * j + 5] = bfhi(w.z); v[8 * j + 6] = bflo(w.w); v[8 * j + 7] = bfhi(w.w); }
#pragma unroll
            for (int e = 0; e < 32; ++e) s += v[e];
            const float mean = wave_sum(s) * (1.f / 2048.f); float q = 0.f;
#pragma unroll
            for (int e = 0; e < 32; ++e) { const float d = v[e] - mean; q += d * d; }
            const float rstd = 1.f / sqrtf(wave_sum(q) * (1.f / 2048.f) + LN_EPS);
            if (lane == 0) { f32x2 ms; ms.x = mean; ms.y = rstd; ((GAS f32x2*)stats)[row] = ms; }
        }
        {
            int vslot = 0;
            for (int item = bx; item < 256; item += G) { const int h = item & 7, c = (item >> 3) >> 4, y = (item >> 3) & 15;
                for (int pass = 0; pass < 2; ++pass) { const int qb = pass == 0 ? 31 - y : y;
                    att2::Blk b;
                    b.Q = (const att::bf16*)QH + ((size_t)(h * 2 + c) * S + (size_t)qb * 256) * 128;
                    b.K = (const att::bf16*)KH + (size_t)(h * 2 + c) * S * 128;
                    b.V = (const att::bf16*)VH + (size_t)(h * 2) * S * 128;
                    b.O = OPART + ((size_t)(h * 2 + c) * S + (size_t)qb * 256) * 256;
                    b.P0 = qb * 256;
                    att2::diff_attn_block(b, (size_t)S * 128, (char*)lds + RING_OFF, vslot); } }
        }
        if (BOTH(2)) GRID_BAR();
    }

    if (IN(3)) {
        float a1 = lq1[lane] * lk1[lane] + lq1[lane + 64] * lk1[lane + 64], a2 = lq2[lane] * lk2[lane] + lq2[lane + 64] * lk2[lane + 64];
        a1 = wave_sum(a1); a2 = wave_sum(a2);
        const float lam = __builtin_amdgcn_exp2f(a1 * 1.4426950408889634f) - __builtin_amdgcn_exp2f(a2 * 1.4426950408889634f) + LAMBDA_INIT;
        const int d = lane * 4;
        const f32x4 sw = *(const f32x4*)(subln_w + d);
        for (int it0 = gw; it0 < S * NHEAD; it0 += 4 * NGW) { f32x4 o0[4], o1[4];
#pragma unroll
            for (int u = 0; u < 4; ++u) { const int it = it0 + u * NGW, t = it >> 3, h = it & 7;
                if (it < S * NHEAD) { o0[u] = *(const GAS f32x4*)(OPART + ((size_t)(h * 2 + 0) * S + t) * 256 + d);
                                      o1[u] = *(const GAS f32x4*)(OPART + ((size_t)(h * 2 + 1) * S + t) * 256 + d); }
                else { o0[u] = (f32x4){0.f, 0.f, 0.f, 0.f}; o1[u] = o0[u]; } }
#pragma unroll
            for (int u = 0; u < 4; ++u) { const int it = it0 + u * NGW, t = it >> 3, h = it & 7;
                const f32x4 df = o0[u] - lam * o1[u];
                const float ss = wave_sum((df.x * df.x + df.y * df.y) + (df.z * df.z + df.w * df.w));
                const float r = (1.0f - LAMBDA_INIT) / sqrtf(ss * (1.f / 256.f) + LN_EPS);
                const f32x4 y = df * r * sw; v2u w; w.x = pk2(y.x, y.y); w.y = pk2(y.z, y.w);
                if (it < S * NHEAD) *(GAS v2u*)(YA + (size_t)t * 4096 + h * 256 + d) = w; } }
        for (int it = vcu; it < (S / CHUNK) * NGRP; it += G) sgu_item((char*)lds + RING_OFF, it >> 3, it & 7, GS, GU, stats, sgu_ln_g, sgu_ln_b, w_spatial, b_spatial, YA);
        if (BOTH(3)) GRID_BAR();
    }

    if (IN(4)) {
        pg8::StaticOrder so; so.init(S, DM, G, bx);
        { pg8::Gemm g{YA, WPA_T, S, DM, 4096}; pg8::EpiGate2 E{SGA, SGB, MERGED}; pg8::gemm_phase<pg8::EpiGate2, pg8::StaticOrder, true, true>(ldsl + RING_OFF, g, so, E); }
        if (BOTH(4)) GRID_BAR();
    }

    if (IN(5)) {
        pg8::Gemm g{MERGED, WOUT_T, S, DM, DM}; pg8::StaticOrder so; so.init(S, DM, G, bx);
        pg8::EpiResB<false> E{x, R1, nullptr, ALPHA};
        pg8::gemm_phase<pg8::EpiResB<false>, pg8::StaticOrder, true, true>(ldsl + RING_OFF, g, so, E);
        if (BOTH(5)) GRID_BAR();
    }

    if (IN(6)) {
        { const float wmi8s = t8scale(w_mi, lane);
          for (int row = gw; row < S; row += NGW) ln_row_4096_b8(R1 + (size_t)row * DM, H1B + (size_t)row * DM, H18 + (size_t)row * DM, h1s + row, wmi8s, ln1_g, ln1_b, lane); }
        if (BOTH(6)) GRID_BAR();
    }

    if (IN(7)) {
        constexpr int N8 = MI8_TILES * 256;
        { pg8::Gemm g{(const bf16*)H18, (const bf16*)WMI8_T, S, N8, DM}; pg8::StaticOrder so; so.init(S, N8, G, bx);
          pg8::EpiRelu2<true> E{Z, DFF, b_mi, h1s};
          pg8::gemm_phase<pg8::EpiRelu2<true>, pg8::StaticOrder, true, true, false, true>(ldsl + RING_OFF, g, so, E); }
        { pg8::Gemm g{H1B, WMI_T + (size_t)N8 * DM, S, DFF - N8, DM}; pg8::StaticOrder so; so.init(S, DFF - N8, G, bx);
          pg8::EpiRelu2<false> E{Z + N8, DFF, b_mi + N8};
          pg8::gemm_phase<pg8::EpiRelu2<false>, pg8::StaticOrder, true, true>(ldsl + RING_OFF, g, so, E); }
        if (BOTH(7)) GRID_BAR();
    }

    if (IN(8)) {
        pg8::Gemm g{Z, WMO_T, S, DM, DFF}; pg8::StaticOrder so; so.init(S, DM, G, bx);
        pg8::EpiResB<true> E{H1B, R2, b_mo, ALPHA};
        pg8::gemm_phase<pg8::EpiResB<true>, pg8::StaticOrder, true, true>(ldsl + RING_OFF, g, so, E);
        if (BOTH(8)) GRID_BAR();
    }

    if (IN(9)) {
        for (int row = gw; row < S; row += NGW) ln_row_4096_bf(R2 + (size_t)row * DM, out + (size_t)row * DM, ln2_g, ln2_b, lane);
    }
#undef IN
#undef BOTH
#undef GRID_BAR
}

extern "C" void kernel_launch(void* const* d_in, const int* in_sizes, int n_in, void* d_out, int out_size, void* d_ws, size_t ws_size, hipStream_t stream) {
    static int grid = 0;
    if (grid == 0) {
        if (n_in != 22 || in_sizes[0] != S * DM || out_size != S * DM || ws_size < WS_END) { fprintf(stderr, "kernel_launch: built for 22 inputs, x/out of %d floats, >= %zu bytes of workspace; got n_in %d, in0 %d, out %d, ws %zu; nothing launched\n", S * DM, (size_t)WS_END, n_in, n_in > 0 ? in_sizes[0] : -1, out_size, ws_size); grid = -1; return; }
        int dev = 0, cus = 0, per_cu = 0;
        if (hipGetDevice(&dev) != hipSuccess || hipDeviceGetAttribute(&cus, hipDeviceAttributeMultiprocessorCount, dev) != hipSuccess) { fprintf(stderr, "kernel_launch: hipGetDevice / hipDeviceGetAttribute failed\n"); grid = -1; return; }
        if (hipFuncSetAttribute((const void*)mk_fwd, hipFuncAttributeMaxDynamicSharedMemorySize, LDS_BYTES) != hipSuccess) { fprintf(stderr, "kernel_launch: hipFuncSetAttribute failed\n"); grid = -1; return; }
        if (hipOccupancyMaxActiveBlocksPerMultiprocessor(&per_cu, (const void*)mk_fwd, NWAVES * 64, LDS_BYTES) != hipSuccess || per_cu < 1)
            fprintf(stderr, "kernel_launch: note: the occupancy query reports %d workgroups per CU\n", per_cu);
        (void)hipGetLastError();
        grid = cus;
    }
    if (grid < 0) return;
    if (hipMemsetAsync((char*)d_ws + WS_CTL, 0, CTL_ZERO_BYTES, stream) != hipSuccess) { fprintf(stderr, "kernel_launch: hipMemsetAsync failed\n"); return; }
    Args a{};
    for (int i = 0; i < 22; ++i) a.in[i] = (const float*)d_in[i];
    a.out = (float*)d_out; a.ws = (unsigned char*)d_ws;
#if MK_ONE_LAUNCH
    a.ph_lo = 0; a.ph_hi = N_PHASES;
    hipLaunchKernelGGL(mk_fwd, dim3(grid), dim3(NWAVES * 64), LDS_BYTES, stream, a);
#else
#ifndef PROBE_REP
#define PROBE_REP -1
#endif
    for (int p = 0; p < N_PHASES; ++p) { a.ph_lo = p; a.ph_hi = p + 1; for (int r = 0; r < (p == PROBE_REP ? 2 : 1); ++r) hipLaunchKernelGGL(mk_fwd, dim3(grid), dim3(NWAVES * 64), LDS_BYTES, stream, a); }
#endif
    const hipError_t le = hipPeekAtLastError();
    if (le != hipSuccess) fprintf(stderr, "kernel_launch: launch failed: %s\n", hipGetErrorName(le));
}
```
